# Optimizing an MI355X kernel written in HIP

```python
import math
import jax, jax.numpy as jnp
from jax import lax
import numpy as np

D_MODEL = 1024
BATCH = 4
SEQ = 8192
DEPTH = 2

HEAD_DIM = 64
Q_BLOCK = 128
NEG_INF = -1e30
LN_EPS = 1e-5
RMS_EPS = 1e-6
DN_ALPHA = (2.0 * DEPTH) ** 0.25
DN_BETA = (8.0 * DEPTH) ** -0.25
D_FF = 4 * D_MODEL

MLA_HEADS = (D_MODEL // 2) // HEAD_DIM
MLA_Q_RANK = D_MODEL // 4
MLA_KV_RANK = D_MODEL // 4
MLA_NOPE = 64
MLA_ROPE = 32
MLA_V = HEAD_DIM
ROPE_THETA = 10000.0

NSA_HEADS = (D_MODEL // 2) // HEAD_DIM
NSA_KV_GROUPS = 2
NSA_CMP_LEN = 32
NSA_CMP_STRIDE = 16
NSA_SEL_LEN = 64
NSA_SEL_TOPK = 16
NSA_WINDOW = 512
NSA_FORCE_BONUS = 1e3

DIFF_HEADS = D_MODEL // (2 * HEAD_DIM)
DIFF_D = HEAD_DIM

L0_SPLITS = (MLA_Q_RANK, MLA_KV_RANK, MLA_ROPE, NSA_HEADS * HEAD_DIM) + (NSA_KV_GROUPS * HEAD_DIM,) * 6 + (3 * NSA_HEADS,)
L0_IN_WIDTH = sum(L0_SPLITS)
L0_V_SEGMENTS = (5, 7, 9)
L0_MIX_WIDTH = MLA_HEADS * MLA_V + NSA_HEADS * HEAD_DIM

kernel_name = 'hybrid_mla_nsa_diffattn_deepnorm'


def layer_norm(x, g, b):
    xf = x.astype(jnp.float32)
    mu = jnp.mean(xf, axis=-1, keepdims=True)
    var = jnp.mean(jnp.square(xf - mu), axis=-1, keepdims=True)
    return ((xf - mu) * lax.rsqrt(var + LN_EPS) * g + b).astype(x.dtype)


def rms_norm(x, g):
    xf = x.astype(jnp.float32)
    return (xf * lax.rsqrt(jnp.mean(jnp.square(xf), axis=-1, keepdims=True) + RMS_EPS) * g).astype(x.dtype)


def rope_tables(seq):
    inv = 1.0 / (ROPE_THETA ** (jnp.arange(0, MLA_ROPE, 2, dtype=jnp.float32) / MLA_ROPE))
    ang = jnp.arange(seq, dtype=jnp.float32)[:, None] * inv[None, :]
    return jnp.cos(ang), jnp.sin(ang)


def apply_rope(x, cos, sin):
    x1, x2 = jnp.split(x.astype(jnp.float32), 2, axis=-1)
    return jnp.concatenate([x1 * cos - x2 * sin, x1 * sin + x2 * cos], axis=-1).astype(x.dtype)


def alibi_slopes(n):
    return jnp.asarray(2.0 ** (-8.0 * np.arange(1, n + 1) / n), dtype=jnp.float32)


def to_blocks(a):
    b, s = a.shape[:2]
    return jnp.moveaxis(a.reshape(b, s // Q_BLOCK, Q_BLOCK, *a.shape[2:]), 1, 0)


def from_blocks(a):
    a = jnp.moveaxis(a, 0, 1)
    return a.reshape(a.shape[0], a.shape[1] * a.shape[2], *a.shape[3:])


def block_starts(s):
    return jnp.arange(s // Q_BLOCK, dtype=jnp.int32) * Q_BLOCK


def causal_probs(q_blk, k, start, scale, slopes):
    sc = jnp.einsum('bqhd,bkhd->bhqk', q_blk, k, preferred_element_type=jnp.float32) * scale
    qpos = start + jnp.arange(Q_BLOCK)
    dist = (qpos[:, None] - jnp.arange(k.shape[1])[None, :]).astype(jnp.float32)
    if slopes is not None:
        sc = sc - slopes[None, :, None, None] * dist
    return jax.nn.softmax(jnp.where(dist >= 0, sc, NEG_INF), axis=-1)


def mla_core(q, k, v):
    scale = q.shape[-1] ** -0.5

    def block(args):
        qb, start = args
        p = causal_probs(qb, k, start, scale, None)
        return jnp.einsum('bhqk,bkhd->bqhd', p.astype(v.dtype), v)

    return from_blocks(lax.map(block, (to_blocks(q), block_starts(q.shape[1]))))


def compress_blocks(t, pos_emb, w1, w2):
    b, s, g, d = t.shape
    n_c = (s - NSA_CMP_LEN) // NSA_CMP_STRIDE + 1
    idx = jnp.arange(n_c)[:, None] * NSA_CMP_STRIDE + jnp.arange(NSA_CMP_LEN)[None, :]
    blk = t[:, idx] + pos_emb[:, None, :]
    flat = jnp.swapaxes(blk, 2, 3).reshape(b, n_c, g, NSA_CMP_LEN * d)
    return jax.nn.gelu(flat @ w1) @ w2


def cmp_to_sel_overlap(n_c, n_s):
    c0 = jnp.arange(n_c)[:, None] * NSA_CMP_STRIDE
    s0 = jnp.arange(n_s)[None, :] * NSA_SEL_LEN
    ov = jnp.minimum(c0 + NSA_CMP_LEN, s0 + NSA_SEL_LEN) - jnp.maximum(c0, s0)
    return jnp.maximum(ov, 0).astype(jnp.float32) / NSA_CMP_LEN


def nsa_core(q, k_c, v_c, k_s, v_s, k_w, v_w, gates):
    b, s, h, d = q.shape
    g, hg = NSA_KV_GROUPS, NSA_HEADS // NSA_KV_GROUPS
    n_c = k_c.shape[1]
    n_s = s // NSA_SEL_LEN
    top = min(NSA_SEL_TOPK, n_s)
    scale = d ** -0.5
    slopes = alibi_slopes(h).reshape(g, hg)[None, :, :, None, None]
    cmp_end = jnp.arange(n_c) * NSA_CMP_STRIDE + (NSA_CMP_LEN - 1)
    overlap = cmp_to_sel_overlap(n_c, n_s)
    k_blocks = jnp.transpose(k_s.reshape(b, n_s, NSA_SEL_LEN, g, d), (0, 3, 1, 2, 4))
    v_blocks = jnp.transpose(v_s.reshape(b, n_s, NSA_SEL_LEN, g, d), (0, 3, 1, 2, 4))
    pad = ((0, 0), (NSA_WINDOW, 0), (0, 0), (0, 0))
    k_wp = jnp.pad(k_w, pad)
    v_wp = jnp.pad(v_w, pad)
    bi = jnp.arange(b)[:, None, None, None]
    gi = jnp.arange(g)[None, :, None, None]
    sel_off = jnp.arange(NSA_SEL_LEN)
    blk_ids = jnp.arange(n_s)
    win_off = jnp.arange(NSA_WINDOW + Q_BLOCK)
    n_sel_keys = top * NSA_SEL_LEN

    def block(args):
        qb, gb, start = args
        qg = qb.reshape(b, Q_BLOCK, g, hg, d)
        qpos = start + jnp.arange(Q_BLOCK)
        dist = (qpos[:, None] - cmp_end[None, :]).astype(jnp.float32)
        valid = dist >= 0
        sc = jnp.einsum('bqghd,bcgd->bghqc', qg, k_c, preferred_element_type=jnp.float32) * scale
        sc = jnp.where(valid, sc - slopes * dist, NEG_INF)
        p_c = jnp.where(valid, jax.nn.softmax(sc, axis=-1), 0.0)
        o_c = jnp.einsum('bghqc,bcgd->bqghd', p_c.astype(v_c.dtype), v_c)
        imp = jnp.einsum('bghqc,cn->bgqn', p_c, overlap)
        cur = (qpos // NSA_SEL_LEN)[:, None]
        forced = (blk_ids == 0) | (blk_ids == cur) | (blk_ids == cur - 1)
        imp = jnp.where(blk_ids <= cur, imp + NSA_FORCE_BONUS * forced.astype(jnp.float32), NEG_INF)
        _, sel = lax.top_k(imp, top)
        ks = k_blocks[bi, gi, sel].reshape(b, g, Q_BLOCK, n_sel_keys, d)
        vs = v_blocks[bi, gi, sel].reshape(b, g, Q_BLOCK, n_sel_keys, d)
        kpos = (sel[..., None] * NSA_SEL_LEN + sel_off).reshape(b, g, Q_BLOCK, n_sel_keys)
        dist = (qpos[:, None] - kpos).astype(jnp.float32)[:, :, None]
        sc = jnp.einsum('bqghd,bgqkd->bghqk', qg, ks, preferred_element_type=jnp.float32) * scale
        sc = jnp.where(dist >= 0, sc - slopes * dist, NEG_INF)
        o_s = jnp.einsum('bghqk,bgqkd->bqghd', jax.nn.softmax(sc, axis=-1).astype(vs.dtype), vs)
        kw = lax.dynamic_slice_in_dim(k_wp, start, NSA_WINDOW + Q_BLOCK, axis=1)
        vw = lax.dynamic_slice_in_dim(v_wp, start, NSA_WINDOW + Q_BLOCK, axis=1)
        kpos_w = start - NSA_WINDOW + win_off
        dist_i = qpos[:, None] - kpos_w[None, :]
        valid = (dist_i >= 0) & (dist_i < NSA_WINDOW) & (kpos_w[None, :] >= 0)
        sc = jnp.einsum('bqghd,bkgd->bghqk', qg, kw, preferred_element_type=jnp.float32) * scale
        sc = jnp.where(valid, sc - slopes * dist_i.astype(jnp.float32), NEG_INF)
        o_w = jnp.einsum('bghqk,bkgd->bqghd', jax.nn.softmax(sc, axis=-1).astype(vw.dtype), vw)
        gg = gb.reshape(b, Q_BLOCK, g, hg, 3)
        o = gg[..., 0:1] * o_c + gg[..., 1:2] * o_s + gg[..., 2:3] * o_w
        return o.reshape(b, Q_BLOCK, h, d)

    return from_blocks(lax.map(block, (to_blocks(q), to_blocks(gates), block_starts(s))))


def mla_nsa_mixer(x, w_in, q_norm, w_uq, kv_norm, w_ukv, pos_k, w1_k, w2_k, pos_v, w1_v, w2_v, w_out, cos, sin):
    b, s, _ = x.shape
    h = x @ w_in
    parts = jnp.split(h, np.cumsum(L0_SPLITS)[:-1].tolist(), axis=-1)
    q_lat, kv_lat, k_rope, nq, nkc, nvc, nks, nvs, nkw, nvw, ng = parts
    q = (rms_norm(q_lat, q_norm) @ w_uq).reshape(b, s, MLA_HEADS, MLA_NOPE + MLA_ROPE)
    q_pe = apply_rope(q[..., MLA_NOPE:], cos[:, None, :], sin[:, None, :])
    kv = (rms_norm(kv_lat, kv_norm) @ w_ukv).reshape(b, s, MLA_HEADS, MLA_NOPE + MLA_V)
    k_pe = apply_rope(k_rope, cos, sin)
    q_full = jnp.concatenate([q[..., :MLA_NOPE], q_pe], axis=-1)
    k_full = jnp.concatenate([kv[..., :MLA_NOPE], jnp.broadcast_to(k_pe[:, :, None, :], (b, s, MLA_HEADS, MLA_ROPE))], axis=-1)
    o_mla = mla_core(q_full, k_full, kv[..., MLA_NOPE:])
    kv_shape = (b, s, NSA_KV_GROUPS, HEAD_DIM)
    k_c = compress_blocks(nkc.reshape(kv_shape), pos_k, w1_k, w2_k)
    v_c = compress_blocks(nvc.reshape(kv_shape), pos_v, w1_v, w2_v)
    gates = jax.nn.sigmoid(ng.reshape(b, s, NSA_HEADS, 3))
    o_nsa = nsa_core(nq.reshape(b, s, NSA_HEADS, HEAD_DIM), k_c, v_c, nks.reshape(kv_shape), nvs.reshape(kv_shape), nkw.reshape(kv_shape), nvw.reshape(kv_shape), gates)
    o = jnp.concatenate([o_mla.reshape(b, s, -1), o_nsa.reshape(b, s, -1)], axis=-1)
    return o @ w_out


def diff_mixer(x, w_qkv, lam_q1, lam_k1, lam_q2, lam_k2, subln_g, w_o, layer_idx):
    b, s, _ = x.shape
    q, k, v = jnp.split(x @ w_qkv, 3, axis=-1)
    q = q.reshape(b, s, DIFF_HEADS, 2, DIFF_D)
    k = k.reshape(b, s, DIFF_HEADS, 2, DIFF_D)
    v = v.reshape(b, s, DIFF_HEADS, 2 * DIFF_D)
    k1, k2 = k[..., 0, :], k[..., 1, :]
    lam_init = 0.8 - 0.6 * math.exp(-0.3 * layer_idx)
    lam = (jnp.exp(jnp.sum(lam_q1.astype(jnp.float32) * lam_k1.astype(jnp.float32)))
           - jnp.exp(jnp.sum(lam_q2.astype(jnp.float32) * lam_k2.astype(jnp.float32))) + lam_init)
    slopes = alibi_slopes(DIFF_HEADS)
    scale = DIFF_D ** -0.5

    def block(args):
        qb, start = args
        p1 = causal_probs(qb[..., 0, :], k1, start, scale, slopes)
        p2 = causal_probs(qb[..., 1, :], k2, start, scale, slopes)
        return jnp.einsum('bhqk,bkhe->bqhe', (p1 - lam * p2).astype(v.dtype), v)

    o = from_blocks(lax.map(block, (to_blocks(q), block_starts(s))))
    o = rms_norm(o, subln_g) * (1.0 - lam_init)
    return o.reshape(b, s, -1) @ w_o


def channel_mixer(x, w_up, w_down, ln_g, ln_b):
    y = jnp.square(jax.nn.relu(x @ w_up)) @ w_down
    return layer_norm(DN_ALPHA * x + y, ln_g, ln_b)


def _w(k, shape, fan_in, gain=1.0):
    return jax.random.normal(k, shape, jnp.float32) * (gain * fan_in ** -0.5)


def _gain(k, n):
    return 1.0 + 0.02 * jax.random.normal(k, (n,), jnp.float32)


def _bias(k, n):
    return 0.02 * jax.random.normal(k, (n,), jnp.float32)


def setup_inputs(seed: int = 0) -> dict:
    key = jax.random.key(seed)
    ks = iter(jax.random.split(key, 40))
    d = D_MODEL
    cmp_in = NSA_CMP_LEN * HEAD_DIM
    in_scale = jnp.concatenate([jnp.full((n,), DN_BETA if i in L0_V_SEGMENTS else 1.0, jnp.float32) for i, n in enumerate(L0_SPLITS)])
    ukv_scale = jnp.tile(jnp.concatenate([jnp.ones((MLA_NOPE,), jnp.float32), jnp.full((MLA_V,), DN_BETA, jnp.float32)]), MLA_HEADS)
    qkv_scale = jnp.concatenate([jnp.ones((2 * d,), jnp.float32), jnp.full((d,), DN_BETA, jnp.float32)])
    return {
        'x': jax.random.normal(next(ks), (BATCH, SEQ, d), jnp.float32),
        'l0_w_in': _w(next(ks), (d, L0_IN_WIDTH), d) * in_scale,
        'l0_mla_q_norm': _gain(next(ks), MLA_Q_RANK),
        'l0_mla_w_uq': _w(next(ks), (MLA_Q_RANK, MLA_HEADS * (MLA_NOPE + MLA_ROPE)), MLA_Q_RANK),
        'l0_mla_kv_norm': _gain(next(ks), MLA_KV_RANK),
        'l0_mla_w_ukv': _w(next(ks), (MLA_KV_RANK, MLA_HEADS * (MLA_NOPE + MLA_V)), MLA_KV_RANK) * ukv_scale,
        'l0_nsa_cmp_pos_k': 0.1 * jax.random.normal(next(ks), (NSA_CMP_LEN, HEAD_DIM), jnp.float32),
        'l0_nsa_cmp_w1_k': _w(next(ks), (cmp_in, HEAD_DIM), cmp_in),
        'l0_nsa_cmp_w2_k': _w(next(ks), (HEAD_DIM, HEAD_DIM), HEAD_DIM),
        'l0_nsa_cmp_pos_v': 0.1 * jax.random.normal(next(ks), (NSA_CMP_LEN, HEAD_DIM), jnp.float32),
        'l0_nsa_cmp_w1_v': _w(next(ks), (cmp_in, HEAD_DIM), cmp_in),
        'l0_nsa_cmp_w2_v': _w(next(ks), (HEAD_DIM, HEAD_DIM), HEAD_DIM),
        'l0_w_out': _w(next(ks), (L0_MIX_WIDTH, d), L0_MIX_WIDTH, DN_BETA),
        'l0_ln_mix_g': _gain(next(ks), d),
        'l0_ln_mix_b': _bias(next(ks), d),
        'l0_w_up': _w(next(ks), (d, D_FF), d, DN_BETA),
        'l0_w_down': _w(next(ks), (D_FF, d), D_FF, DN_BETA),
        'l0_ln_ffn_g': _gain(next(ks), d),
        'l0_ln_ffn_b': _bias(next(ks), d),
        'l1_w_qkv': _w(next(ks), (d, 3 * d), d) * qkv_scale,
        'l1_lam_q1': 0.1 * jax.random.normal(next(ks), (DIFF_D,), jnp.float32),
        'l1_lam_k1': 0.1 * jax.random.normal(next(ks), (DIFF_D,), jnp.float32),
        'l1_lam_q2': 0.1 * jax.random.normal(next(ks), (DIFF_D,), jnp.float32),
        'l1_lam_k2': 0.1 * jax.random.normal(next(ks), (DIFF_D,), jnp.float32),
        'l1_subln_g': _gain(next(ks), 2 * DIFF_D),
        'l1_w_o': _w(next(ks), (d, d), d, DN_BETA),
        'l1_ln_mix_g': _gain(next(ks), d),
        'l1_ln_mix_b': _bias(next(ks), d),
        'l1_w_up': _w(next(ks), (d, D_FF), d, DN_BETA),
        'l1_w_down': _w(next(ks), (D_FF, d), D_FF, DN_BETA),
        'l1_ln_ffn_g': _gain(next(ks), d),
        'l1_ln_ffn_b': _bias(next(ks), d),
    }


def reference(x, l0_w_in, l0_mla_q_norm, l0_mla_w_uq, l0_mla_kv_norm, l0_mla_w_ukv,
              l0_nsa_cmp_pos_k, l0_nsa_cmp_w1_k, l0_nsa_cmp_w2_k, l0_nsa_cmp_pos_v, l0_nsa_cmp_w1_v, l0_nsa_cmp_w2_v,
              l0_w_out, l0_ln_mix_g, l0_ln_mix_b, l0_w_up, l0_w_down, l0_ln_ffn_g, l0_ln_ffn_b,
              l1_w_qkv, l1_lam_q1, l1_lam_k1, l1_lam_q2, l1_lam_k2, l1_subln_g, l1_w_o,
              l1_ln_mix_g, l1_ln_mix_b, l1_w_up, l1_w_down, l1_ln_ffn_g, l1_ln_ffn_b):
    cos, sin = rope_tables(x.shape[1])
    mixer_params = [
        (l0_w_in, l0_mla_q_norm, l0_mla_w_uq, l0_mla_kv_norm, l0_mla_w_ukv, l0_nsa_cmp_pos_k, l0_nsa_cmp_w1_k,
         l0_nsa_cmp_w2_k, l0_nsa_cmp_pos_v, l0_nsa_cmp_w1_v, l0_nsa_cmp_w2_v, l0_w_out),
        (l1_w_qkv, l1_lam_q1, l1_lam_k1, l1_lam_q2, l1_lam_k2, l1_subln_g, l1_w_o),
    ]
    mix_norms = [(l0_ln_mix_g, l0_ln_mix_b), (l1_ln_mix_g, l1_ln_mix_b)]
    ffn_params = [(l0_w_up, l0_w_down, l0_ln_ffn_g, l0_ln_ffn_b), (l1_w_up, l1_w_down, l1_ln_ffn_g, l1_ln_ffn_b)]
    for i in range(DEPTH):
        if i % 2 == 0:
            y = mla_nsa_mixer(x, *mixer_params[i], cos, sin)
        else:
            y = diff_mixer(x, *mixer_params[i], i)
        x = layer_norm(DN_ALPHA * x + y, *mix_norms[i])
        x = channel_mixer(x, *ffn_params[i])
    return x
```

```cpp
#include <hip/hip_runtime.h>
#include <hip/hip_cooperative_groups.h>
#include <cstdio>
#include <cstdint>
namespace cg = cooperative_groups;
namespace pg8 {
#define PG8_LAS __attribute__((address_space(3)))
typedef unsigned short bf16_t;
typedef short bf16x8 __attribute__((ext_vector_type(8)));
typedef float f32x4 __attribute__((ext_vector_type(4)));
typedef unsigned u32x4 __attribute__((ext_vector_type(4)));
constexpr int BM = 256, BK = 64, HALF = 128, HTB = HALF * BK * 2  , STAGE_BYTES = 8 * HTB, NXCD = 8, WGM = 8;

__host__ __device__ __forceinline__ int lds_byte(int r, int c) { const int st = (r >> 4) * 2 + (c >> 5), rr = r & 15, cc = c & 31, ob = rr * 64 + cc * 2; return st * 1024 + (ob ^ (((ob >> 9) & 1) << 5)); }
__host__ __device__ __forceinline__ void stage_rc(int b, int& R, int& C) { const int st = b / 1024, sb = b % 1024, swz = sb ^ (((sb >> 9) & 1) << 5); R = (st >> 1) * 16 + swz / 64; C = (st & 1) * 32 + (swz % 64) / 2; }
__host__ __device__ __forceinline__ int perm32(int rho) { const int n = rho >> 4, i = rho & 15; return 8 * (i >> 2) + 4 * n + (i & 3); }

struct Unit { int pm, pn; };
struct Gemm { const bf16_t* A; const bf16_t* Bt; int M, N, K; };

struct StaticOrder {
    int nM, nN, nwg, G, c;
    __host__ __device__ void init(int M, int N, int G_, int c_) { nM = M / BM; nN = N / BM; nwg = nM * nN; G = G_; c = c_; }
    __host__ __device__ bool next(int i, Unit& u) const {
        const long L = (long)i * G + c; if (L >= nwg) return false;
        int wgid = (int)L; { const int q = nwg / NXCD, r = nwg % NXCD, xcd = wgid % NXCD, off = wgid / NXCD; wgid = (xcd < r ? xcd * (q + 1) : r * (q + 1) + (xcd - r) * q) + off; }
        const int nig = WGM * nN, gid = wgid / nig, fm = gid * WGM, gsz = (nM - fm) < WGM ? (nM - fm) : WGM;
        u.pm = fm + ((wgid % nig) % gsz); u.pn = (wgid % nig) / gsz; return true;
    }
    __device__ __forceinline__ void a_ready(const Unit&) const {}
    __device__ __forceinline__ void done(const Unit&) const {}
};

typedef float f32x2 __attribute__((ext_vector_type(2)));
typedef __bf16 bf16x2_t __attribute__((ext_vector_type(2)));
__device__ __forceinline__ unsigned cvt_pk_bf16(float lo, float hi) { f32x2 v = {lo, hi}; bf16x2_t b = __builtin_convertvector(v, bf16x2_t); return __builtin_bit_cast(unsigned, b); }
__device__ __forceinline__ float act_apply(float v, int ACT) {
    if (ACT == 2) { const float r = v > 0.f ? v : 0.f; return r * r; }
    if (ACT == 3) { const float u = 0.7978845608028654f * (v + 0.044715f * v * v * v); const float e = __builtin_amdgcn_exp2f(u * 2.8853900817779268f); const float th = 1.f - 2.f * __builtin_amdgcn_rcpf(e + 1.f); return 0.5f * v * (1.f + th); }
    return v;
}
template <int ACT> struct EpiB16 {
    static constexpr bool PERM = true, AFTER_DRAIN = false;
    bf16_t* O; int ldc;
    __device__ __forceinline__ void operator()(const f32x4 (&acc)[2][2][4][2], const Unit& u, int wr, int wc, int fr, int fq) const {
        const int row0 = u.pm * BM + wr * 64 + fr; const int col0 = u.pn * BM + wc * 32 + 8 * fq;
#pragma unroll
        for (int ai = 0; ai < 2; ++ai)
#pragma unroll
            for (int m = 0; m < 4; ++m) { bf16_t* rowp = O + (size_t)(row0 + ai * HALF + m * 16) * ldc + col0;
#pragma unroll
                for (int bj = 0; bj < 2; ++bj) { f32x4 v0 = acc[ai][bj][m][0], v1 = acc[ai][bj][m][1];
                    if (ACT != 0) {
#pragma unroll
                        for (int e = 0; e < 4; ++e) { v0[e] = act_apply(v0[e], ACT); v1[e] = act_apply(v1[e], ACT); } }
                    u32x4 w; w.x = cvt_pk_bf16(v0[0], v0[1]); w.y = cvt_pk_bf16(v0[2], v0[3]); w.z = cvt_pk_bf16(v1[0], v1[1]); w.w = cvt_pk_bf16(v1[2], v1[3]);
                    *(u32x4*)(rowp + bj * HALF) = w; } }
    }
};
template <int ACT> struct EpiF32 {
    static constexpr bool PERM = false, AFTER_DRAIN = false;
    float* O; int ldc;
    __device__ __forceinline__ void operator()(const f32x4 (&acc)[2][2][4][2], const Unit& u, int wr, int wc, int fr, int fq) const {
        const int row0 = u.pm * BM + wr * 64 + fr; const int col0 = u.pn * BM + wc * 32 + 4 * fq;
#pragma unroll
        for (int ai = 0; ai < 2; ++ai)
#pragma unroll
            for (int m = 0; m < 4; ++m) { float* rowp = O + (size_t)(row0 + ai * HALF + m * 16) * ldc + col0;
#pragma unroll
                for (int bj = 0; bj < 2; ++bj)
#pragma unroll
                    for (int n = 0; n < 2; ++n) { f32x4 v = acc[ai][bj][m][n];
#pragma unroll
                        for (int e = 0; e < 4; ++e) v[e] = act_apply(v[e], ACT);
                        *(f32x4*)(rowp + bj * HALF + n * 16) = v; } }
    }
};
template <int MODE> struct EpiResid {
    static constexpr bool PERM = false, AFTER_DRAIN = false;
    const float* base; const float* stats; const float* g; const float* b; float* out; float alpha;
    __device__ __forceinline__ void operator()(const f32x4 (&acc)[2][2][4][2], const Unit& u, int wr, int wc, int fr, int fq) const {
        const int row0 = u.pm * BM + wr * 64 + fr; const int col0 = u.pn * BM + wc * 32 + 4 * fq;
#pragma unroll
        for (int ai = 0; ai < 2; ++ai)
#pragma unroll
            for (int m = 0; m < 4; ++m) { const int r = row0 + ai * HALF + m * 16; const size_t off = (size_t)r * 1024 + col0;
                float mean = 0.f, rstd = 1.f; if (MODE == 1) { const f32x2 st = *(const f32x2*)(stats + 2 * (size_t)r); mean = st.x; rstd = st.y; }
#pragma unroll
                for (int bj = 0; bj < 2; ++bj)
#pragma unroll
                    for (int n = 0; n < 2; ++n) { f32x4 bs = *(const f32x4*)(base + off + bj * HALF + n * 16);
                        if (MODE == 1) { const f32x4 gv = *(const f32x4*)(g + col0 + bj * HALF + n * 16), bv = *(const f32x4*)(b + col0 + bj * HALF + n * 16); bs = (bs - mean) * rstd * gv + bv; }
                        *(f32x4*)(out + off + bj * HALF + n * 16) = bs * alpha + acc[ai][bj][m][n]; }
                asm volatile("" ::: "memory"); }
    }
};

template <class Epi, class Sched, bool ALIGN_EPI = false, bool SP2 = false>
__device__ __forceinline__ void gemm_phase(PG8_LAS unsigned char* lds, const Gemm g, const Sched& S, const Epi& E) {
    const int tid = threadIdx.x, wid = __builtin_amdgcn_readfirstlane(tid >> 6), lane = tid & 63, wr = wid >> 2, wc = wid & 3, fr = lane & 15, fq = lane >> 4;
    const int K = g.K, nt = K / BK;
    unsigned voffA[2], voffB[2];
#pragma unroll
    for (int i = 0; i < 2; ++i) { int R, C; stage_rc(tid * 16 + i * 8192, R, C); const int Rb = Epi::PERM ? ((R & ~31) + perm32(R & 31)) : R;
        voffA[i] = (unsigned)(R * K + C) * 2u; voffB[i] = (unsigned)(Rb * K + C) * 2u; }
    const size_t kstep = (size_t)(BK * 2);
    const size_t hstep = (size_t)HALF * K * 2;
    const size_t tstep = 2 * hstep;
    const unsigned ldsw = (unsigned)wid * 1024u;
    const int aoff = lds_byte(wr * 64 + fr, fq * 8), boff = lds_byte(wc * 32 + fr, fq * 8);
#define PG8_SA(b, h) (((b) * 2 + (h)) * HTB)
#define PG8_SB(b, h) ((4 + (b) * 2 + (h)) * HTB)
#define PG8_STAGE(bufoff, gbase, voff) do { _Pragma("unroll") for (int _i = 0; _i < 2; ++_i) \
        __builtin_amdgcn_global_load_lds((const unsigned*)((const char*)(gbase) + (voff)[_i]), (PG8_LAS unsigned*)(lds + (bufoff) + ldsw + _i * 8192), 16, 0, 0); } while (0)
#define PG8_LDA(dst, b, h) do { _Pragma("unroll") for (int m = 0; m < 4; ++m) _Pragma("unroll") for (int k = 0; k < 2; ++k) dst[m][k] = *(const PG8_LAS bf16x8*)(lds + PG8_SA(b, h) + aoff + m * 2048 + k * 1024); } while (0)
#define PG8_LDB(dst, b, h) do { _Pragma("unroll") for (int n = 0; n < 2; ++n) _Pragma("unroll") for (int k = 0; k < 2; ++k) dst[n][k] = *(const PG8_LAS bf16x8*)(lds + PG8_SB(b, h) + boff + n * 2048 + k * 1024); } while (0)
#define PG8_MMA(ai, bj, At, Bt) do { __builtin_amdgcn_s_setprio(1); _Pragma("unroll") for (int m = 0; m < 4; ++m) _Pragma("unroll") for (int n = 0; n < 2; ++n) _Pragma("unroll") for (int k = 0; k < 2; ++k) \
        acc[ai][bj][m][n] = __builtin_amdgcn_mfma_f32_16x16x32_bf16(Bt[n][k], At[m][k], acc[ai][bj][m][n], 0, 0, 0); __builtin_amdgcn_s_setprio(0); } while (0)
#define PG8_WAIT_V(n) asm volatile("s_waitcnt vmcnt(" #n ")" ::: "memory")
#define PG8_WAIT_L(n) asm volatile("s_waitcnt lgkmcnt(" #n ")" ::: "memory")
#define PG8_BAR __builtin_amdgcn_s_barrier()
#define PG8_SCHED __builtin_amdgcn_sched_barrier(0)
    Unit cur, nxt; int ui = 0;
    if (!S.next(0, cur)) return;
    f32x4 acc[2][2][4][2];
#pragma unroll
    for (int a = 0; a < 2; ++a)
#pragma unroll
        for (int b = 0; b < 2; ++b)
#pragma unroll
            for (int m = 0; m < 4; ++m)
#pragma unroll
                for (int n = 0; n < 2; ++n) acc[a][b][m][n] = (f32x4){0.f, 0.f, 0.f, 0.f};
    bf16x8 At[4][2], B0[2][2], B1[2][2];
    const char* cA = (const char*)g.A + (size_t)cur.pm * tstep; const char* cB = (const char*)g.Bt + (size_t)cur.pn * tstep;
    S.a_ready(cur);
    if constexpr (SP2) {
        PG8_STAGE(PG8_SB(0, 0), cB, voffB); PG8_STAGE(PG8_SB(0, 1), cB + hstep, voffB); PG8_STAGE(PG8_SA(0, 0), cA, voffA); PG8_STAGE(PG8_SA(0, 1), cA + hstep, voffA);
        if (wr == 1) PG8_BAR;
        PG8_WAIT_V(2); PG8_BAR;
        PG8_STAGE(PG8_SB(1, 0), cB + kstep, voffB); PG8_STAGE(PG8_SA(1, 0), cA + kstep, voffA); PG8_STAGE(PG8_SB(1, 1), cB + hstep + kstep, voffB);
        PG8_WAIT_V(6); PG8_BAR;
    } else {
        PG8_STAGE(PG8_SB(0, 0), cB, voffB); PG8_STAGE(PG8_SA(0, 0), cA, voffA); PG8_STAGE(PG8_SB(0, 1), cB + hstep, voffB); PG8_STAGE(PG8_SA(0, 1), cA + hstep, voffA);
        if (wr == 1) PG8_BAR;
        PG8_WAIT_V(4); PG8_BAR;
        PG8_STAGE(PG8_SB(1, 0), cB + kstep, voffB); PG8_STAGE(PG8_SA(1, 0), cA + kstep, voffA); PG8_STAGE(PG8_SB(1, 1), cB + hstep + kstep, voffB);
        PG8_WAIT_V(6); PG8_BAR;
    }
    for (;;) {
        const bool has_next = S.next(ui + 1, nxt);
        const char* nA = has_next ? (const char*)g.A + (size_t)nxt.pm * tstep : cA; const char* nB = has_next ? (const char*)g.Bt + (size_t)nxt.pn * tstep : cB;
        for (int t = 0; t < nt; t += 2) {
            const bool last = (t == nt - 2);
            const char* a1 = cA + (size_t)(t + 1) * kstep;
            const char* a2 = last ? nA : cA + (size_t)(t + 2) * kstep; const char* b2 = last ? nB : cB + (size_t)(t + 2) * kstep;
            const char* a3 = a2 + kstep; const char* b3 = b2 + kstep;
            if (last && has_next) S.a_ready(nxt);
            if constexpr (SP2) {
            PG8_LDB(B0, 0, 0); PG8_LDB(B1, 0, 1); PG8_SCHED; PG8_LDA(At, 0, 0); PG8_STAGE(PG8_SA(1, 1), a1 + hstep, voffA);
            PG8_WAIT_V(8); PG8_WAIT_L(0); PG8_BAR; PG8_MMA(0, 0, At, B0); PG8_MMA(0, 1, At, B1); PG8_BAR; PG8_SCHED;
            PG8_LDA(At, 0, 1); PG8_STAGE(PG8_SB(0, 0), b2, voffB); PG8_STAGE(PG8_SB(0, 1), b2 + hstep, voffB); PG8_STAGE(PG8_SA(0, 0), a2, voffA);
            PG8_WAIT_V(8); PG8_WAIT_L(0); PG8_BAR; PG8_MMA(1, 0, At, B0); PG8_MMA(1, 1, At, B1); PG8_BAR; PG8_SCHED;
            PG8_LDB(B0, 1, 0); PG8_LDB(B1, 1, 1); PG8_SCHED; PG8_LDA(At, 1, 0); PG8_STAGE(PG8_SA(0, 1), a2 + hstep, voffA);
            PG8_WAIT_V(8); PG8_WAIT_L(0); PG8_BAR; PG8_MMA(0, 0, At, B0); PG8_MMA(0, 1, At, B1); PG8_BAR; PG8_SCHED;
            PG8_LDA(At, 1, 1); PG8_STAGE(PG8_SB(1, 0), b3, voffB); PG8_STAGE(PG8_SB(1, 1), b3 + hstep, voffB); PG8_STAGE(PG8_SA(1, 0), a3, voffA);
            PG8_WAIT_V(8); PG8_WAIT_L(0); PG8_BAR; PG8_MMA(1, 0, At, B0); PG8_MMA(1, 1, At, B1); PG8_BAR; PG8_SCHED;
            } else {
            PG8_LDB(B0, 0, 0); PG8_SCHED; PG8_LDA(At, 0, 0); PG8_STAGE(PG8_SA(1, 1), a1 + hstep, voffA);
            PG8_WAIT_L(8); PG8_BAR; PG8_WAIT_L(0); PG8_MMA(0, 0, At, B0); PG8_BAR; PG8_SCHED;
            PG8_LDB(B1, 0, 1); PG8_STAGE(PG8_SB(0, 0), b2, voffB);
            PG8_BAR; PG8_WAIT_L(0); PG8_MMA(0, 1, At, B1); PG8_BAR;
            PG8_LDA(At, 0, 1); PG8_STAGE(PG8_SA(0, 0), a2, voffA);
            PG8_BAR; PG8_WAIT_L(0); PG8_MMA(1, 0, At, B0); PG8_BAR; PG8_SCHED;
            PG8_STAGE(PG8_SB(0, 1), b2 + hstep, voffB);
            PG8_WAIT_V(6); PG8_BAR; PG8_MMA(1, 1, At, B1); PG8_BAR;
            PG8_LDB(B0, 1, 0); PG8_SCHED; PG8_LDA(At, 1, 0); PG8_STAGE(PG8_SA(0, 1), a2 + hstep, voffA);
            PG8_WAIT_L(8); PG8_BAR; PG8_WAIT_L(0); PG8_MMA(0, 0, At, B0); PG8_BAR; PG8_SCHED;
            PG8_LDB(B1, 1, 1); PG8_STAGE(PG8_SB(1, 0), b3, voffB);
            PG8_BAR; PG8_WAIT_L(0); PG8_MMA(0, 1, At, B1); PG8_BAR;
            PG8_LDA(At, 1, 1); PG8_STAGE(PG8_SA(1, 0), a3, voffA);
            PG8_BAR; PG8_WAIT_L(0); PG8_MMA(1, 0, At, B0); PG8_BAR; PG8_SCHED;
            PG8_STAGE(PG8_SB(1, 1), b3 + hstep, voffB);
            PG8_WAIT_V(6); PG8_BAR; PG8_MMA(1, 1, At, B1); PG8_BAR;
            }
        }
        if constexpr (ALIGN_EPI) { if (wr == 0) PG8_BAR; }
        if constexpr (!Epi::AFTER_DRAIN) { E(acc, cur, wr, wc, fr, fq); S.done(cur); }
        if (!has_next) break;
#pragma unroll
        for (int a = 0; a < 2; ++a)
#pragma unroll
            for (int b = 0; b < 2; ++b)
#pragma unroll
                for (int m = 0; m < 4; ++m)
#pragma unroll
                    for (int n = 0; n < 2; ++n) acc[a][b][m][n] = (f32x4){0.f, 0.f, 0.f, 0.f};
        cur = nxt; cA = nA; cB = nB; ++ui;
        if constexpr (ALIGN_EPI) { if (wr == 1) PG8_BAR; }
    }
    PG8_WAIT_V(0);
    if constexpr (!ALIGN_EPI) { if (wr == 0) PG8_BAR; }
    PG8_BAR;
    if constexpr (Epi::AFTER_DRAIN) { E.fused(acc, cur, wr, wc, fr, fq, lds, wid, lane); S.done(cur); }
#undef PG8_SA
#undef PG8_SB
#undef PG8_STAGE
#undef PG8_LDA
#undef PG8_LDB
#undef PG8_MMA
#undef PG8_WAIT_V
#undef PG8_WAIT_L
#undef PG8_BAR
#undef PG8_SCHED
}
}
#define DI __device__ __forceinline__
#define LAS __attribute__((address_space(3)))
typedef unsigned short bf16;
typedef short bf16x8 __attribute__((ext_vector_type(8)));
typedef float f32x16 __attribute__((ext_vector_type(16)));
typedef float f32x4 __attribute__((ext_vector_type(4)));
typedef float f32x2 __attribute__((ext_vector_type(2)));
typedef unsigned u32x4 __attribute__((ext_vector_type(4)));
typedef unsigned u32x2 __attribute__((ext_vector_type(2)));
constexpr int NB = 4, S = 8192, T = NB * S, D = 1024, FF = 4096, HW = 2048  ;
constexpr int C_QLAT = 0, C_KVLAT = 256, C_KROPE = 512, C_NQ = 544, C_KC = 1056, C_VC = 1184, C_KS = 1312, C_VS = 1440, C_KW = 1568, C_VW = 1696, C_GATE = 1824, L0W = 1848;
constexpr float LN_EPS = 1e-5f, RMS_EPS = 1e-6f, ALPHA = 1.4142135623730951f, LOG2E = 1.4426950408889634f, NEGF = -1e30f;
constexpr float LAM_INIT = 0.35550906759096934f;
constexpr size_t MiB = 1u << 20;
constexpr size_t WS_WIN = 0, WS_WUQ = 4 * MiB, WS_WUKV = WS_WUQ + 768 * 256 * 2, WS_W1 = 5 * MiB, WS_WOUT = 6 * MiB, WS_WUP0 = 8 * MiB, WS_WDN0 = 16 * MiB, WS_WQKV = 24 * MiB, WS_WO = 30 * MiB, WS_WUP1 = 32 * MiB, WS_WDN1 = 40 * MiB;
constexpr size_t WS_STATS = 48 * MiB;
constexpr size_t WS_H = 50 * MiB;
constexpr size_t WS_XB = 178 * MiB;
constexpr size_t WS_QLN = 242 * MiB, WS_KVLN = 258 * MiB;
constexpr size_t WS_ACMP = 274 * MiB;
constexpr size_t WS_QRAW = 306 * MiB;
constexpr size_t WS_KV = 354 * MiB;
constexpr size_t WS_VTS = 418 * MiB, WS_VTW = 426 * MiB;
constexpr size_t WS_HID = 242 * MiB;
constexpr size_t WS_QKV = 242 * MiB;
constexpr size_t WS_VTD = 434 * MiB;
constexpr size_t WS_END = 498 * MiB;
constexpr size_t DO_OC = 0, DO_CH = 64 * MiB, DO_ROPE = 72 * MiB, DO_GATE = 73 * MiB, DO_KPE = 76 * MiB, DO_KC = 78 * MiB, DO_VCT = DO_KC + 512 * 1024, DO_SELM = 79 * MiB;
constexpr int LDS_BYTES = 147456;
constexpr size_t WS_CTL = 500 * MiB; constexpr int KN_WORD = 3584;

DI unsigned f2bf(float f) { unsigned u = __builtin_bit_cast(unsigned, f); return (u + 0x7fffu + ((u >> 16) & 1u)) >> 16; }
DI float bf2f(unsigned short h) { return __builtin_bit_cast(float, (unsigned)h << 16); }
DI unsigned pk2(float lo, float hi) { typedef __bf16 b2 __attribute__((ext_vector_type(2))); f32x2 v = {lo, hi}; b2 r = __builtin_convertvector(v, b2); return __builtin_bit_cast(unsigned, r); }
DI float wave_sum(float v) {
#pragma unroll
    for (int o = 1; o < 64; o <<= 1) v += __shfl_xor(v, o);
    return v; }
DI float xh_max(float v) { auto rr = __builtin_amdgcn_permlane32_swap(__float_as_uint(v), __float_as_uint(v), false, false); return fmaxf(__uint_as_float(rr[0]), __uint_as_float(rr[1])); }
DI float xh_sum(float v) { auto rr = __builtin_amdgcn_permlane32_swap(__float_as_uint(v), __float_as_uint(v), false, false); return __uint_as_float(rr[0]) + __uint_as_float(rr[1]); }

#define MFMA32(a, b, c) __builtin_amdgcn_mfma_f32_32x32x16_bf16((a), (b), (c), 0, 0, 0)
enum { M_CAUSAL = 0, M_WINDOW = 1, M_SEL = 2, M_CMP = 3 };
constexpr int STG = 28672;
DI int pi_row(int i) { const int j = i >> 4, w = i & 15; return 16 * j + 8 * ((w >> 2) & 1) + 4 * (w >> 3) + (w & 3); }
struct KVSrc { const bf16* K; int kp; const bf16* K2; const bf16* Vt; int vp; };
struct StageRegs { u32x4 k0, k1, v0, v1; };
template <int DQK, int DV> DI void stage_load(StageRegs& r, const KVSrc& s, int kb, int tid) {
    r.k0 = *(const u32x4*)(s.K + (size_t)(kb + (tid >> 3)) * s.kp + (tid & 7) * 8);
    if (DQK == 96) { if (tid < 256) r.k1 = *(const u32x4*)(s.K2 + (size_t)(kb + (tid >> 2)) * 32 + (tid & 3) * 8); }
    r.v0 = *(const u32x4*)(s.Vt + (size_t)(tid >> 3) * s.vp + kb + (tid & 7) * 8);
    if (DV == 128) r.v1 = *(const u32x4*)(s.Vt + (size_t)(64 + (tid >> 3)) * s.vp + kb + (tid & 7) * 8);
}
template <int DQK, int DV> DI void stage_store(const StageRegs& r, LAS char* buf, int tid) {
    constexpr int KSB = (DQK + 8) * 2, VOFF = 64 * KSB;
    *(LAS u32x4*)(buf + (tid >> 3) * KSB + (tid & 7) * 16) = r.k0;
    if (DQK == 96) { if (tid < 256) *(LAS u32x4*)(buf + (tid >> 2) * KSB + 128 + (tid & 3) * 16) = r.k1; }
    *(LAS u32x4*)(buf + VOFF + (tid >> 3) * 144 + (tid & 7) * 16) = r.v0;
    if (DV == 128) *(LAS u32x4*)(buf + VOFF + (64 + (tid >> 3)) * 144 + (tid & 7) * 16) = r.v1;
}
template <int DQK> DI void qk_tile(f32x16& s0, f32x16& s1, const LAS char* kbuf, const bf16x8 (&qf)[DQK / 16], int koff) {
    constexpr int KSB = (DQK + 8) * 2;
    bf16x8 a0[DQK / 16], a1[DQK / 16];
#pragma unroll
    for (int d0 = 0; d0 < DQK / 16; ++d0) { a0[d0] = *(const LAS bf16x8*)(kbuf + koff + d0 * 32); a1[d0] = *(const LAS bf16x8*)(kbuf + koff + 32 * KSB + d0 * 32); }
    __builtin_amdgcn_sched_barrier(0);
    f32x16 z;
#pragma unroll
    for (int r = 0; r < 16; ++r) z[r] = 0.f;
    s0 = MFMA32(a0[0], qf[0], z); s1 = MFMA32(a1[0], qf[0], z);
#pragma unroll
    for (int d0 = 1; d0 < DQK / 16; ++d0) { s0 = MFMA32(a0[d0], qf[d0], s0); s1 = MFMA32(a1[d0], qf[d0], s1); }
}
DI void v_load4(bf16x8 (&v)[4], const LAS char* vbuf, int voff, int blk) {
#pragma unroll
    for (int j = 0; j < 4; ++j) v[j] = *(const LAS bf16x8*)(vbuf + voff + blk * 32 * 144 + j * 32);
}
template <int MODE, bool ALIBI> DI void score_fix(f32x16& s0, f32x16& s1, float c2, float slope2, int dql, bool need_mask, bool lane_ok) {
    constexpr int KM = (MODE == M_CMP) ? 16 : 1;
    const float bl = ALIBI ? -slope2 * (float)dql : 0.f;
#pragma unroll
    for (int kh = 0; kh < 2; ++kh)
#pragma unroll
        for (int r = 0; r < 16; ++r) { const int kc = KM * (32 * kh + 16 * (r >> 3) + (r & 7));
            float v = kh ? s1[r] : s0[r];
            v = ALIBI ? __builtin_fmaf(v, c2, bl + slope2 * (float)kc) : v * c2;
            if (kh) s1[r] = v; else s0[r] = v; }
    if (need_mask) {
#pragma unroll
        for (int kh = 0; kh < 2; ++kh)
#pragma unroll
            for (int r = 0; r < 16; ++r) { const int kc = KM * (32 * kh + 16 * (r >> 3) + (r & 7));
                bool ok = kc <= dql; if (MODE == M_WINDOW) ok = ok && (kc > dql - 512);
                if (kh) s1[r] = ok ? s1[r] : NEGF; else s0[r] = ok ? s0[r] : NEGF; }
    }
    if (MODE == M_SEL) { if (!lane_ok) {
#pragma unroll
        for (int r = 0; r < 16; ++r) { s0[r] = NEGF; s1[r] = NEGF; } } }
}
DI float mx3(float a, float b, float c) { return __builtin_fmaxf(__builtin_fmaxf(a, b), c); }
DI float tile_max(const f32x16& s0, const f32x16& s1) {
    float a = mx3(s0[0], s0[1], s1[0]), b = mx3(s0[2], s0[3], s1[1]); a = mx3(a, s1[2], s1[3]);
#pragma unroll
    for (int r = 4; r < 16; r += 4) { a = mx3(a, s0[r], s0[r + 1]); b = mx3(b, s0[r + 2], s0[r + 3]); a = mx3(a, s1[r], s1[r + 1]); b = mx3(b, s1[r + 2], s1[r + 3]); }
    return xh_max(fmaxf(a, b)); }
DI void pack_p(bf16x8 (&pf)[4], const f32x16& s0, const f32x16& s1) {
#pragma unroll
    for (int j = 0; j < 2; ++j) { u32x4 w0, w1;
        w0.x = pk2(s0[8 * j], s0[8 * j + 1]); w0.y = pk2(s0[8 * j + 2], s0[8 * j + 3]); w0.z = pk2(s0[8 * j + 4], s0[8 * j + 5]); w0.w = pk2(s0[8 * j + 6], s0[8 * j + 7]);
        w1.x = pk2(s1[8 * j], s1[8 * j + 1]); w1.y = pk2(s1[8 * j + 2], s1[8 * j + 3]); w1.z = pk2(s1[8 * j + 4], s1[8 * j + 5]); w1.w = pk2(s1[8 * j + 6], s1[8 * j + 7]);
        pf[j] = __builtin_bit_cast(bf16x8, w0); pf[2 + j] = __builtin_bit_cast(bf16x8, w1); }
}
template <int DV> DI void pv_tile(f32x16 (&o)[DV / 32], const LAS char* vbuf, const bf16x8 (&pf)[4], int voff, const bf16x8 (&v0)[4]) {
    if (DV == 64) {
        bf16x8 vn[4]; v_load4(vn, vbuf, voff, 1);
        __builtin_amdgcn_sched_barrier(0);
#pragma unroll
        for (int j = 0; j < 4; ++j) o[0] = MFMA32(v0[j], pf[j], o[0]);
#pragma unroll
        for (int j = 0; j < 4; ++j) o[1] = MFMA32(vn[j], pf[j], o[1]);
    } else {
#pragma unroll
        for (int blk = 0; blk < DV / 32; ++blk) {
            bf16x8 vc[4]; v_load4(vc, vbuf, voff, blk);
            __builtin_amdgcn_sched_barrier(0);
#pragma unroll
            for (int j = 0; j < 4; ++j) o[blk] = MFMA32(vc[j], pf[j], o[blk]);
        }
    }
}
template <int MODE> DI int next_tile(int t, int t0, unsigned u0, unsigned u1, unsigned u2, unsigned u3) {
    --t;
    if (MODE == M_SEL) { while (t >= t0) { const unsigned w = (t < 32) ? u0 : (t < 64) ? u1 : (t < 96) ? u2 : u3; if ((w >> (t & 31)) & 1u) break; --t; } }
    return t >= t0 ? t : -1;
}
template <int DQK, bool ALIBI> DI void qk_tile2(f32x16& s0, f32x16& s1, const LAS char* kbuf, const bf16x8 (&qf)[DQK / 16], int koff, bf16x8 qx, bf16x8 kx0) {
    constexpr int KSB = (DQK + 8) * 2, NH = DQK / 32;
    bf16x8 a0[NH], a1[NH];
#pragma unroll
    for (int d0 = 0; d0 < NH; ++d0) { a0[d0] = *(const LAS bf16x8*)(kbuf + koff + d0 * 32); a1[d0] = *(const LAS bf16x8*)(kbuf + koff + 32 * KSB + d0 * 32); }
    __builtin_amdgcn_sched_barrier(0);
    f32x16 z;
#pragma unroll
    for (int r = 0; r < 16; ++r) z[r] = 0.f;
    if (ALIBI) { s0 = MFMA32(kx0, qx, z); s1 = MFMA32(kx0, qx, z); s0 = MFMA32(a0[0], qf[0], s0); s1 = MFMA32(a1[0], qf[0], s1); }
    else { s0 = MFMA32(a0[0], qf[0], z); s1 = MFMA32(a1[0], qf[0], z); }
    bf16x8 b0[DQK / 16 - NH], b1[DQK / 16 - NH];
#pragma unroll
    for (int d0 = NH; d0 < DQK / 16; ++d0) { b0[d0 - NH] = *(const LAS bf16x8*)(kbuf + koff + d0 * 32); b1[d0 - NH] = *(const LAS bf16x8*)(kbuf + koff + 32 * KSB + d0 * 32); }
    __builtin_amdgcn_sched_barrier(0);
#pragma unroll
    for (int d0 = 1; d0 < NH; ++d0) { s0 = MFMA32(a0[d0], qf[d0], s0); s1 = MFMA32(a1[d0], qf[d0], s1); }
#pragma unroll
    for (int d0 = NH; d0 < DQK / 16; ++d0) { s0 = MFMA32(b0[d0 - NH], qf[d0], s0); s1 = MFMA32(b1[d0 - NH], qf[d0], s1); }
}
template <int DQK, int DV, int MODE, bool ALIBI>
DI bool tile_compute(f32x16 (&o)[DV / 32], float& m, float& l, const bf16x8 (&qf)[DQK / 16], bf16x8 qx, bf16x8 kx0, const LAS char* buf, int t, int qpos, int q0w, u32x4 sel,
                     float c2, float slope2, float qbound, int koff, int voff) {
    const int kbase = 64 * t;
    bool lane_ok = true; if (MODE == M_SEL) { const unsigned w = (t < 32) ? sel.x : (t < 64) ? sel.y : (t < 96) ? sel.z : sel.w; lane_ok = (w >> (t & 31)) & 1u; }
    bool skip = (kbase > q0w + 31); if (MODE == M_WINDOW) skip = skip || (kbase + 63 < q0w - 511);
    if (MODE == M_SEL) skip = skip || !__any(lane_ok);
    bool dead = false;
    if (ALIBI) { const int dmin = qpos - kbase - 63; const float ub = qbound - slope2 * (float)(dmin > 0 ? dmin : 0); dead = __all(ub < m - 40.f); skip = skip || dead; }
    if (!skip) {
        f32x16 s0, s1; qk_tile2<DQK, ALIBI>(s0, s1, buf, qf, koff, qx, kx0);
        bf16x8 v0[4]; if (DV == 64) { v_load4(v0, buf, voff, 0); __builtin_amdgcn_sched_barrier(0); }
        bool need_mask = kbase + 63 > q0w; if (MODE == M_WINDOW) need_mask = need_mask || (q0w + 31 - kbase >= 512);
        const int dq = qpos - kbase;
        const float tb = (ALIBI ? -slope2 * (float)dq : 0.f) - m, tb1 = ALIBI ? tb + 32.f * slope2 : tb;
#pragma unroll
        for (int r = 0; r < 16; ++r) { s0[r] = __builtin_fmaf(s0[r], c2, tb); s1[r] = __builtin_fmaf(s1[r], c2, tb1); }
        if (need_mask || MODE == M_SEL) {
            const int dqh = lane_ok ? dq - 8 * (int)((threadIdx.x >> 5) & 1) : -1000000;
#pragma unroll
            for (int kh = 0; kh < 2; ++kh)
#pragma unroll
                for (int r = 0; r < 16; ++r) { const int kc = 32 * kh + 16 * (r >> 3) + (r & 7);
                    bool ok = (kc <= dqh); if (MODE == M_WINDOW) ok = ok && (kc > dqh - 512);
                    if (kh) s1[r] = ok ? s1[r] : NEGF; else s0[r] = ok ? s0[r] : NEGF; }
        }
        const float mx = tile_max(s0, s1);
        if (__any(mx > 6.f)) { const float dl = fmaxf(mx, 0.f), f = __builtin_amdgcn_exp2f(-dl); m += dl; l *= f;
#pragma unroll
            for (int r = 0; r < 16; ++r) { s0[r] -= dl; s1[r] -= dl; }
#pragma unroll
            for (int blk = 0; blk < DV / 32; ++blk) o[blk] *= f; }
        float sum = 0.f;
#pragma unroll
        for (int r = 0; r < 16; ++r) { s0[r] = __builtin_amdgcn_exp2f(s0[r]); s1[r] = __builtin_amdgcn_exp2f(s1[r]); sum += s0[r] + s1[r]; }
        l += sum;
        bf16x8 pf[4]; pack_p(pf, s0, s1);
        pv_tile<DV>(o, buf, pf, voff, v0);
    }
    return dead;
}
template <int DQK, int DV, int MODE, bool ALIBI>
DI void run_tiles(f32x16 (&o)[DV / 32], float& m, float& l, const bf16x8 (&qf)[DQK / 16], const KVSrc& src, int t0, int t1, unsigned u0, unsigned u1, unsigned u2, unsigned u3,
                  int qpos, int q0w, u32x4 sel, float c2, float slope2, float knmax, LAS char* lds, int tid, int lane) {
    constexpr int KSB = (DQK + 8) * 2, VOFF = 64 * KSB;
    const int l31 = lane & 31, hi = lane >> 5;
    const int koff = pi_row(l31) * KSB + hi * 16, voff = VOFF + l31 * 144 + hi * 16;
    bf16x8 qx, kx0; float qbound = 0.f;
#pragma unroll
    for (int e = 0; e < 8; ++e) { qx[e] = 0; kx0[e] = 0; }
    if (ALIBI) {
        const float sq = slope2 / c2; const unsigned sh = f2bf(sq); const float rem = sq - __builtin_bit_cast(float, sh << 16); const unsigned slo = f2bf(rem);
        if (hi == 0) { qx[0] = (short)sh; qx[1] = (short)slo; const short a = (short)f2bf((float)pi_row(l31)); kx0[0] = a; kx0[1] = a; }
        float ss = 0.f;
#pragma unroll
        for (int d0 = 0; d0 < DQK / 16; ++d0)
#pragma unroll
            for (int e = 0; e < 8; ++e) { const float x = bf2f((unsigned short)qf[d0][e]); ss += x * x; }
        qbound = sqrtf(xh_sum(ss)) * knmax * c2 * 1.001f + 0.01f;
    }
    { const bf16* kd = src.K + (size_t)qpos * src.kp + 8 * hi; float dot = 0.f;
#pragma unroll
      for (int d0 = 0; d0 < DQK / 16; ++d0) { const bf16x8 kk = (DQK == 96 && d0 >= 4) ? *(const bf16x8*)(src.K2 + (size_t)qpos * 32 + (d0 - 4) * 16 + 8 * hi) : *(const bf16x8*)(kd + d0 * 16);
#pragma unroll
          for (int e = 0; e < 8; ++e) dot += bf2f((unsigned short)kk[e]) * bf2f((unsigned short)qf[d0][e]); }
      m = xh_sum(dot) * c2; }
    StageRegs sr; int t = t1, cur = 0;
    LAS int* dslot = (LAS int*)(lds + 2 * STG + 256);
    const int wid_ = tid >> 6; bool counted = false;
    if (ALIBI) { if (lane == 0) dslot[wid_] = -1; }
    stage_load<DQK, DV>(sr, src, 64 * t, tid); stage_store<DQK, DV>(sr, lds, tid); __syncthreads();
    while (t >= 0) {
        const int tn = next_tile<MODE>(t, t0, u0, u1, u2, u3);
        if (tn >= 0) stage_load<DQK, DV>(sr, src, 64 * tn, tid);
        const bool dead = tile_compute<DQK, DV, MODE, ALIBI>(o, m, l, qf, qx, kx0, lds + cur * STG, t, qpos, q0w, sel, c2, slope2, qbound, koff, voff);
        if (ALIBI) { if (dead && !counted) { if (lane == 0) dslot[wid_] = t; counted = true; } }
        if (tn >= 0) stage_store<DQK, DV>(sr, lds + (cur ^ 1) * STG, tid);
        __syncthreads();
        if (ALIBI) { const u32x4 d0 = *(const LAS u32x4*)dslot, d1 = *(const LAS u32x4*)(dslot + 4);
            const bool all = (int)d0.x >= t && (int)d0.y >= t && (int)d0.z >= t && (int)d0.w >= t && (int)d1.x >= t && (int)d1.y >= t && (int)d1.z >= t && (int)d1.w >= t;
            if (__builtin_amdgcn_readfirstlane((int)all)) break; }
        cur ^= 1; t = tn;
    }
    __syncthreads();
}
template <int DQK, int DV>
DI void run_tiles2(f32x16 (&o)[DV / 32], float& m, float& l, const bf16x8 (&qf)[DQK / 16], const KVSrc& src, int t1, int qpos, int q0w, float c2, LAS char* lds, int tid, int lane) {
    constexpr int KSB = (DQK + 8) * 2, VOFF = 64 * KSB;
    const int l31 = lane & 31, hi = lane >> 5;
    const int koff = pi_row(l31) * KSB + hi * 16, voff = VOFF + l31 * 144 + hi * 16;
    { const bf16* kd = src.K + (size_t)qpos * src.kp + 8 * hi; float dot = 0.f;
#pragma unroll
      for (int d0 = 0; d0 < DQK / 16; ++d0) { const bf16x8 kk = (DQK == 96 && d0 >= 4) ? *(const bf16x8*)(src.K2 + (size_t)qpos * 32 + (d0 - 4) * 16 + 8 * hi) : *(const bf16x8*)(kd + d0 * 16);
#pragma unroll
          for (int e = 0; e < 8; ++e) dot += bf2f((unsigned short)kk[e]) * bf2f((unsigned short)qf[d0][e]); }
      m = xh_sum(dot) * c2; }
    bf16x8 qx;
#pragma unroll
    for (int e = 0; e < 8; ++e) qx[e] = 0;
    StageRegs ra, rb; int ta = t1, cur = 0;
    stage_load<DQK, DV>(ra, src, 64 * ta, tid); stage_load<DQK, DV>(rb, src, 64 * (ta - 1), tid);
    stage_store<DQK, DV>(ra, lds, tid); stage_store<DQK, DV>(rb, lds + STG, tid); __syncthreads();
    while (ta >= 0) {
        const int tn = ta - 2;
        if (tn >= 0) { stage_load<DQK, DV>(ra, src, 64 * tn, tid); stage_load<DQK, DV>(rb, src, 64 * (tn - 1), tid); }
        const LAS char* bufa = lds + (2 * cur) * STG; const LAS char* bufb = bufa + STG;
        const int kba = 64 * ta, kbb = kba - 64;
        if (!(kbb > q0w + 31)) {
            f32x16 a0, a1, b0, b1;
            { f32x16 z;
#pragma unroll
              for (int r = 0; r < 16; ++r) z[r] = 0.f;
              a0 = z; a1 = z; b0 = z; b1 = z;
              bf16x8 fa0 = *(const LAS bf16x8*)(bufa + koff), fa1 = *(const LAS bf16x8*)(bufa + koff + 32 * KSB), fb0 = *(const LAS bf16x8*)(bufb + koff), fb1 = *(const LAS bf16x8*)(bufb + koff + 32 * KSB);
#pragma unroll
              for (int d0 = 0; d0 < DQK / 16; ++d0) {
                  bf16x8 na0 = fa0, na1 = fa1, nb0 = fb0, nb1 = fb1;
                  if (d0 + 1 < DQK / 16) { na0 = *(const LAS bf16x8*)(bufa + koff + (d0 + 1) * 32); na1 = *(const LAS bf16x8*)(bufa + koff + 32 * KSB + (d0 + 1) * 32); nb0 = *(const LAS bf16x8*)(bufb + koff + (d0 + 1) * 32); nb1 = *(const LAS bf16x8*)(bufb + koff + 32 * KSB + (d0 + 1) * 32); }
                  __builtin_amdgcn_sched_barrier(0);
                  a0 = MFMA32(fa0, qf[d0], a0); a1 = MFMA32(fa1, qf[d0], a1); b0 = MFMA32(fb0, qf[d0], b0); b1 = MFMA32(fb1, qf[d0], b1);
                  fa0 = na0; fa1 = na1; fb0 = nb0; fb1 = nb1; } }
            const float tb = -m;
#pragma unroll
            for (int r = 0; r < 16; ++r) { a0[r] = __builtin_fmaf(a0[r], c2, tb); a1[r] = __builtin_fmaf(a1[r], c2, tb); b0[r] = __builtin_fmaf(b0[r], c2, tb); b1[r] = __builtin_fmaf(b1[r], c2, tb); }
            if (kba + 63 > q0w) { const int dqa = qpos - kba - 8 * hi, dqb = dqa + 64;
#pragma unroll
                for (int kh = 0; kh < 2; ++kh)
#pragma unroll
                    for (int r = 0; r < 16; ++r) { const int kc = 32 * kh + 16 * (r >> 3) + (r & 7); const bool oka = (kc <= dqa), okb = (kc <= dqb);
                        if (kh) { a1[r] = oka ? a1[r] : NEGF; b1[r] = okb ? b1[r] : NEGF; } else { a0[r] = oka ? a0[r] : NEGF; b0[r] = okb ? b0[r] : NEGF; } } }
            const float mx = fmaxf(tile_max(a0, a1), tile_max(b0, b1));
            if (__any(mx > 6.f)) { const float dl = fmaxf(mx, 0.f), f = __builtin_amdgcn_exp2f(-dl); m += dl; l *= f;
#pragma unroll
                for (int r = 0; r < 16; ++r) { a0[r] -= dl; a1[r] -= dl; b0[r] -= dl; b1[r] -= dl; }
#pragma unroll
                for (int blk = 0; blk < DV / 32; ++blk) o[blk] *= f; }
            float sum = 0.f;
#pragma unroll
            for (int r = 0; r < 16; ++r) { a0[r] = __builtin_amdgcn_exp2f(a0[r]); a1[r] = __builtin_amdgcn_exp2f(a1[r]); b0[r] = __builtin_amdgcn_exp2f(b0[r]); b1[r] = __builtin_amdgcn_exp2f(b1[r]); sum += (a0[r] + a1[r]) + (b0[r] + b1[r]); }
            l += sum;
            bf16x8 pa[4], pb[4]; pack_p(pa, a0, a1); pack_p(pb, b0, b1);
#pragma unroll
            for (int blk = 0; blk < DV / 32; ++blk) {
                { bf16x8 vc[4]; v_load4(vc, bufa, voff, blk); __builtin_amdgcn_sched_barrier(0);
#pragma unroll
                  for (int j = 0; j < 4; ++j) o[blk] = MFMA32(vc[j], pa[j], o[blk]); }
                { bf16x8 vc[4]; v_load4(vc, bufb, voff, blk); __builtin_amdgcn_sched_barrier(0);
#pragma unroll
                  for (int j = 0; j < 4; ++j) o[blk] = MFMA32(vc[j], pb[j], o[blk]); }
            }
        }
        if (tn >= 0) { stage_store<DQK, DV>(ra, lds + (2 * (cur ^ 1)) * STG, tid); stage_store<DQK, DV>(rb, lds + (2 * (cur ^ 1) + 1) * STG, tid); }
        __syncthreads();
        cur ^= 1; ta = tn;
    }
}
template <int DQK> DI void load_q(bf16x8 (&qf)[DQK / 16], const bf16* Qrow, int hi) {
#pragma unroll
    for (int d0 = 0; d0 < DQK / 16; ++d0) qf[d0] = *(const bf16x8*)(Qrow + d0 * 16 + hi * 8);
}
template <int DV> DI void store_o_bf16(const f32x16 (&o)[DV / 32], float inv, bf16* dst, int hi) {
#pragma unroll
    for (int blk = 0; blk < DV / 32; ++blk)
#pragma unroll
        for (int rr = 0; rr < 4; ++rr) { u32x2 w; w.x = pk2(o[blk][4 * rr] * inv, o[blk][4 * rr + 1] * inv); w.y = pk2(o[blk][4 * rr + 2] * inv, o[blk][4 * rr + 3] * inv);
            *(u32x2*)(dst + 32 * blk + 8 * rr + 4 * hi) = w; }
}
#define RLX_AGENT __ATOMIC_RELAXED, __HIP_MEMORY_SCOPE_AGENT
#define XB_TMO      128
#define XB_XCNT(j)  (256  + 64 * (j))
#define XB_XSUB(j)  (1280 + 64 * (j))
#define XB_XGEN(j)  (2304 + 64 * (j))
#define XB_TOP      3328
#define XB_TOPGEN   3392
#define XCD_BAR_WORDS 3456
#define XB_SPIN_CAP (1u << 18)

__device__ __forceinline__ unsigned xb_ld(unsigned* p)              { return __hip_atomic_load(p, __ATOMIC_RELAXED, __HIP_MEMORY_SCOPE_AGENT); }
__device__ __forceinline__ unsigned xb_add(unsigned* p, unsigned v) { return __hip_atomic_fetch_add(p, v, __ATOMIC_RELAXED, __HIP_MEMORY_SCOPE_AGENT); }
__device__ __forceinline__ unsigned xb_xcc_id() { return (unsigned)__builtin_amdgcn_s_getreg((3 << 11) | 20) & 0xFu; }
#define XB_SPIN(cond, bar) do { unsigned _sp = 0; while (cond) { __builtin_amdgcn_s_sleep(1); \
    if ((++_sp & 255u) == 0u) { if (xb_ld(&(bar)[XB_TMO])) break; if (_sp > XB_SPIN_CAP) { atomicAdd(&(bar)[XB_TMO], 1u); break; } } } } while (0)

struct XcdBarrier {
    unsigned* bar; unsigned x;
    volatile LAS unsigned* st;
};

__device__ __forceinline__ XcdBarrier xcd_barrier_post(unsigned* bar, volatile LAS unsigned* st) {
    XcdBarrier b; b.bar = bar; b.x = xb_xcc_id(); b.st = st;
    if (threadIdx.x == 0) (void)xb_add(&bar[XB_XCNT(b.x)], 1u);
    return b;
}
__device__ __forceinline__ void xcd_barrier_complete(unsigned* bar, unsigned x, unsigned& nloc, unsigned& nx) {
    const unsigned G = gridDim.x * gridDim.y * gridDim.z;
    unsigned sum, cnt, mine, sp = 0u;
    for (;;) {
        sum = 0u; cnt = 0u; mine = 0u;
#pragma unroll
        for (unsigned j = 0; j < 16; ++j) { const unsigned c = xb_ld(&bar[XB_XCNT(j)]); sum += c; cnt += (c > 0u) ? 1u : 0u; mine = (j == x) ? c : mine; }
        if (sum == G) break;
        __builtin_amdgcn_s_sleep(1);
        if ((++sp & 255u) == 0u) { if (xb_ld(&bar[XB_TMO])) break; if (sp > XB_SPIN_CAP) { atomicAdd(&bar[XB_TMO], 1u); break; } }
    }
    nloc = mine > 0u ? mine : 1u; nx = cnt > 0u ? cnt : 1u;
}

__device__ __forceinline__ void xcd_barrier(const XcdBarrier& b) {
    asm volatile("s_waitcnt vmcnt(0)" ::: "memory");
    __syncthreads();
    if (threadIdx.x == 0) {
        unsigned* bar = b.bar;
        __builtin_amdgcn_s_waitcnt(0);
        unsigned nloc = b.st[0], nx = b.st[1];
        if (nloc == 0u) { xcd_barrier_complete(bar, b.x, nloc, nx); b.st[0] = nloc; b.st[1] = nx; }
        const unsigned old = xb_add(&bar[XB_XSUB(b.x)], 1u);
        const unsigned gen = old / nloc;
        if (old + 1u == (gen + 1u) * nloc) {
            __builtin_amdgcn_fence(__ATOMIC_RELEASE, "agent");
            asm volatile("s_waitcnt vmcnt(0)" ::: "memory");
            const unsigned og = xb_add(&bar[XB_TOP], 1u);
            const unsigned tg = og / nx;
            if (og + 1u == (tg + 1u) * nx) xb_add(&bar[XB_TOPGEN], 1u);
            else XB_SPIN(xb_ld(&bar[XB_TOPGEN]) == tg, bar);
            __builtin_amdgcn_fence(__ATOMIC_ACQUIRE, "agent");
            xb_add(&bar[XB_XGEN(b.x)], 1u);
            asm volatile("s_waitcnt vmcnt(0)" ::: "memory");
        } else {
            XB_SPIN(xb_ld(&bar[XB_XGEN(b.x)]) == gen, bar);
            __builtin_amdgcn_fence(__ATOMIC_ACQUIRE, "agent");
            asm volatile("s_waitcnt vmcnt(0)" ::: "memory");
        }
    }
    __syncthreads();
}
struct Ptrs {
    const float* in[32]; float* out; unsigned char* ws; unsigned char* dob;
};
DI int vcu_of(int bid, int G) { return (G % 8 == 0) ? (bid % 8) * (G / 8) + bid / 8 : bid; }

DI void mla_unit(const Ptrs& P, int b, int h, int qb, LAS char* lds, int tid, int lane, int wid) {
    asm volatile("" : "+v"(tid), "+v"(lane));
    const int l31 = lane & 31, hi = lane >> 5, q0 = qb * 256, q0w = q0 + 32 * wid, qpos = q0w + l31;
    const bf16* Qrow = (const bf16*)(P.ws + WS_QRAW) + (size_t)(b * S + qpos) * 768 + h * 96;
    bf16x8 qf[6]; load_q<96>(qf, Qrow, hi);
    { const f32x2* rp = (const f32x2*)(P.dob + DO_ROPE) + (size_t)qpos * 16 + 8 * hi; u32x4 a = __builtin_bit_cast(u32x4, qf[4]), c = __builtin_bit_cast(u32x4, qf[5]); unsigned ra[4], rc[4];
#pragma unroll
      for (int e = 0; e < 4; ++e) { const unsigned wa = a[e], wc = c[e]; const f32x2 cs0 = rp[2 * e], cs1 = rp[2 * e + 1];
          const float x1a = bf2f((unsigned short)(wa & 0xffffu)), x1b = bf2f((unsigned short)(wa >> 16)), x2a = bf2f((unsigned short)(wc & 0xffffu)), x2b = bf2f((unsigned short)(wc >> 16));
          ra[e] = pk2(x1a * cs0.x - x2a * cs0.y, x1b * cs1.x - x2b * cs1.y); rc[e] = pk2(x1a * cs0.y + x2a * cs0.x, x1b * cs1.y + x2b * cs1.x); }
      qf[4] = __builtin_bit_cast(bf16x8, (u32x4){ra[0], ra[1], ra[2], ra[3]}); qf[5] = __builtin_bit_cast(bf16x8, (u32x4){rc[0], rc[1], rc[2], rc[3]}); }
    KVSrc src; src.K = (const bf16*)(P.ws + WS_KV) + (size_t)(b * S) * 1024 + h * 128; src.kp = 1024; src.K2 = (const bf16*)(P.dob + DO_KPE) + (size_t)(b * S) * 32;
    src.Vt = (const bf16*)(P.ws + WS_QLN) + (size_t)((b * 8 + h) * 64) * S; src.vp = S;
    f32x16 o[2];
#pragma unroll
    for (int r = 0; r < 16; ++r) { o[0][r] = 0.f; o[1][r] = 0.f; }
    float m = NEGF, l = 0.f;
    run_tiles2<96, 64>(o, m, l, qf, src, (q0 + 255) >> 6, qpos, q0w, 0.10206207261596577f * LOG2E, lds, tid, lane);
    const float inv = 1.f / xh_sum(l);
    store_o_bf16<64>(o, inv, (bf16*)(P.ws + WS_XB) + (size_t)(b * S + qpos) * 1024 + h * 64, hi);
}
DI void diff_unit(const Ptrs& P, int b, int h, int j, int qb, LAS char* lds, int tid, int lane, int wid) {
    asm volatile("" : "+v"(tid), "+v"(lane));
    const int l31 = lane & 31, hi = lane >> 5, q0 = qb * 256, q0w = q0 + 32 * wid, qpos = q0w + l31;
    const bf16* QKV = (const bf16*)(P.ws + WS_QKV);
    bf16x8 qf[4]; load_q<64>(qf, QKV + (size_t)(b * S + qpos) * 3072 + h * 128 + j * 64, hi);
    KVSrc src; src.K = QKV + (size_t)(b * S) * 3072 + 1024 + h * 128 + j * 64; src.kp = 3072; src.K2 = nullptr;
    src.Vt = (const bf16*)(P.ws + WS_VTD) + (size_t)((b * 8 + h) * 128) * S; src.vp = S;
    f32x16 o[4];
#pragma unroll
    for (int r = 0; r < 16; ++r) { o[0][r] = 0.f; o[1][r] = 0.f; o[2][r] = 0.f; o[3][r] = 0.f; }
    float m = NEGF, l = 0.f;
    const float slope2 = __builtin_amdgcn_exp2f(-(float)(h + 1)) * LOG2E;
    const float knmax = sqrtf(__builtin_bit_cast(float, ((const unsigned*)(P.ws + WS_CTL))[KN_WORD + (b * 8 + h) * 2 + j]));
    run_tiles<64, 128, M_CAUSAL, true>(o, m, l, qf, src, 0, (q0 + 255) >> 6, 0u, 0u, 0u, 0u, qpos, q0w, (u32x4){0u, 0u, 0u, 0u}, 0.125f * LOG2E, slope2, knmax, lds, tid, lane);
    const float inv = 1.f / xh_sum(l);
    store_o_bf16<128>(o, inv, (bf16*)P.dob + (size_t)(b * S + qpos) * 2048 + h * 256 + j * 128, hi);
}
DI void nsa_sw_unit(const Ptrs& P, int b, int h, int qb, LAS char* lds, int tid, int lane, int wid) {
    asm volatile("" : "+v"(tid), "+v"(lane));
    const int l31 = lane & 31, hi = lane >> 5, q0 = qb * 256, q0w = q0 + 32 * wid, qpos = q0w + l31, g = h >> 2;
    const bf16* Hb = (const bf16*)(P.ws + WS_H);
    bf16x8 qf[4]; load_q<64>(qf, Hb + (size_t)(b * S + qpos) * HW + C_NQ + h * 64, hi);
    const float slope2 = __builtin_amdgcn_exp2f(-(float)(h + 1)) * LOG2E, c2 = 0.125f * LOG2E;
    f32x16 ow[2], os[2];
#pragma unroll
    for (int r = 0; r < 16; ++r) { ow[0][r] = 0.f; ow[1][r] = 0.f; os[0][r] = 0.f; os[1][r] = 0.f; }
    { KVSrc src; src.K = Hb + (size_t)(b * S) * HW + C_KW + g * 64; src.kp = HW; src.K2 = nullptr; src.Vt = (const bf16*)(P.ws + WS_VTW) + (size_t)((b * 2 + g) * 64) * S; src.vp = S;
      float m = NEGF, l = 0.f; int t0 = (q0 - 511) >> 6; if (t0 < 0) t0 = 0;
      run_tiles<64, 64, M_WINDOW, true>(ow, m, l, qf, src, t0, (q0 + 255) >> 6, 0u, 0u, 0u, 0u, qpos, q0w, (u32x4){0u, 0u, 0u, 0u}, c2, slope2, sqrtf(__builtin_bit_cast(float, ((const unsigned*)(P.ws + WS_CTL))[KN_WORD + 64 + 8 + b * 2 + g])), lds, tid, lane);
      const float inv = 1.f / xh_sum(l); ow[0] *= inv; ow[1] *= inv; }
    const u32x4 sel = *(const u32x4*)((const unsigned*)(P.dob + DO_SELM) + (size_t)((b * 2 + g) * S + qpos) * 4);
    unsigned u0 = sel.x, u1 = sel.y, u2 = sel.z, u3 = sel.w;
#pragma unroll
    for (int o = 1; o < 64; o <<= 1) { u0 |= __shfl_xor(u0, o); u1 |= __shfl_xor(u1, o); u2 |= __shfl_xor(u2, o); u3 |= __shfl_xor(u3, o); }
    LAS unsigned* ex = (LAS unsigned*)(lds + 2 * STG);
    if (lane == 0) { ex[wid * 4] = u0; ex[wid * 4 + 1] = u1; ex[wid * 4 + 2] = u2; ex[wid * 4 + 3] = u3; }
    __syncthreads();
    u0 = u1 = u2 = u3 = 0u;
#pragma unroll
    for (int w = 0; w < 8; ++w) { u0 |= ex[w * 4]; u1 |= ex[w * 4 + 1]; u2 |= ex[w * 4 + 2]; u3 |= ex[w * 4 + 3]; }
    u0 = __builtin_amdgcn_readfirstlane(u0) | 1u; u1 = __builtin_amdgcn_readfirstlane(u1); u2 = __builtin_amdgcn_readfirstlane(u2); u3 = __builtin_amdgcn_readfirstlane(u3);
    { KVSrc src; src.K = Hb + (size_t)(b * S) * HW + C_KS + g * 64; src.kp = HW; src.K2 = nullptr; src.Vt = (const bf16*)(P.ws + WS_VTS) + (size_t)((b * 2 + g) * 64) * S; src.vp = S;
      float m = NEGF, l = 0.f;
      run_tiles<64, 64, M_SEL, true>(os, m, l, qf, src, 0, (q0 + 255) >> 6, u0, u1, u2, u3, qpos, q0w, sel, c2, slope2, sqrtf(__builtin_bit_cast(float, ((const unsigned*)(P.ws + WS_CTL))[KN_WORD + 64 + b * 2 + g])), lds, tid, lane);
      const float inv = 1.f / xh_sum(l); os[0] *= inv; os[1] *= inv; }
    const size_t row = (size_t)(b * S + qpos);
    const float* gp = (const float*)(P.dob + DO_GATE) + row * 24 + h * 3; const float g0 = gp[0], g1 = gp[1], g2 = gp[2];
    const float* oc = (const float*)(P.dob + DO_OC) + row * 512 + h * 64; bf16* dst = (bf16*)(P.ws + WS_XB) + row * 1024 + 512 + h * 64;
#pragma unroll
    for (int blk = 0; blk < 2; ++blk)
#pragma unroll
        for (int rr = 0; rr < 4; ++rr) { const int d = 32 * blk + 8 * rr + 4 * hi; const f32x4 c = *(const f32x4*)(oc + d); float v[4];
#pragma unroll
            for (int e = 0; e < 4; ++e) v[e] = g0 * c[e] + g1 * os[blk][4 * rr + e] + g2 * ow[blk][4 * rr + e];
            u32x2 w; w.x = pk2(v[0], v[1]); w.y = pk2(v[2], v[3]); *(u32x2*)(dst + d) = w; }
}
constexpr int CSTG = 18432, C_PROW = 2 * CSTG, C_IMPH = C_PROW + 8 * 32 * 272;
DI void cmp_unit(const Ptrs& P, int b, int g, int qblk, LAS char* lds, int tid, int lane, int wid) {
    asm volatile("" : "+v"(tid), "+v"(lane));
    const int l31 = lane & 31, hi = lane >> 5, hh = wid & 3, qs = wid >> 2, h = 4 * g + hh, q0 = qblk * 64, q0w = q0 + 32 * qs, qpos = q0w + l31;
    const bf16* Hb = (const bf16*)(P.ws + WS_H);
    bf16x8 qf[4]; load_q<64>(qf, Hb + (size_t)(b * S + qpos) * HW + C_NQ + h * 64, hi);
    const float slope2 = __builtin_amdgcn_exp2f(-(float)(h + 1)) * LOG2E, c2 = 0.125f * LOG2E;
    KVSrc src; src.K = (const bf16*)(P.dob + DO_KC) + (size_t)((b * 2 + g) * 512) * 64; src.kp = 64; src.K2 = nullptr; src.Vt = (const bf16*)(P.dob + DO_VCT) + (size_t)((b * 2 + g) * 64) * 512; src.vp = 512;
    const int nt = (((q0 + 32) >> 4) >> 6) + 1;
    constexpr int KSB = 144, VOFF = 64 * KSB;
    const int koff = pi_row(l31) * KSB + hi * 16, voff = VOFF + l31 * 144 + hi * 16;
    float m = NEGF, l = 0.f; StageRegs sr;
    stage_load<64, 64>(sr, src, 0, tid); stage_store<64, 64>(sr, lds, tid); __syncthreads();
    for (int t = 0; t < nt; ++t) {
        if (t + 1 < nt) stage_load<64, 64>(sr, src, 64 * (t + 1), tid);
        const LAS char* buf = lds + (t & 1) * CSTG;
        f32x16 s0, s1; qk_tile<64>(s0, s1, buf, qf, koff);
        const int dql = qpos - 31 - 1024 * t - 128 * hi;
        score_fix<M_CMP, true>(s0, s1, c2, slope2, dql, 1024 * t + 1039 > q0w, true);
        const float mx = tile_max(s0, s1), mn = fmaxf(m, mx); l *= __builtin_amdgcn_exp2f(m - mn); m = mn;
        float sum = 0.f;
#pragma unroll
        for (int r = 0; r < 16; ++r) sum += __builtin_amdgcn_exp2f(s0[r] - m) + __builtin_amdgcn_exp2f(s1[r] - m);
        l += sum;
        if (t + 1 < nt) stage_store<64, 64>(sr, lds + ((t + 1) & 1) * CSTG, tid);
        __syncthreads();
    }
    const float inv = (m > -1e29f) ? 1.f / xh_sum(l) : 0.f;
    f32x16 o[2];
#pragma unroll
    for (int r = 0; r < 16; ++r) { o[0][r] = 0.f; o[1][r] = 0.f; }
    LAS float* prow = (LAS float*)(lds + C_PROW) + (wid * 32 + l31) * 68;
    float* impg = (float*)(P.ws + WS_ACMP) + (size_t)((b * 2 + g) * 128) * S + q0;
    float carry = 0.f;
    stage_load<64, 64>(sr, src, 0, tid); stage_store<64, 64>(sr, lds, tid); __syncthreads();
    for (int t = 0; t <= nt; ++t) {
        if (t > 0) {
            const LAS float* ih = (const LAS float*)(lds + C_IMPH) + ((t - 1) & 1) * 4096; const int q = tid & 63, nb = (tid >> 6) * 2;
            f32x2 a = *(const LAS f32x2*)(ih + q * 16 + nb); a += *(const LAS f32x2*)(ih + 1024 + q * 16 + nb); a += *(const LAS f32x2*)(ih + 2048 + q * 16 + nb); a += *(const LAS f32x2*)(ih + 3072 + q * 16 + nb);
            impg[(size_t)(16 * (t - 1) + nb) * S + q] = a.x; impg[(size_t)(16 * (t - 1) + nb + 1) * S + q] = a.y;
        }
        if (t == nt) break;
        if (t + 1 < nt) stage_load<64, 64>(sr, src, 64 * (t + 1), tid);
        const LAS char* buf = lds + (t & 1) * CSTG;
        f32x16 s0, s1; qk_tile<64>(s0, s1, buf, qf, koff);
        const int dql = qpos - 31 - 1024 * t - 128 * hi;
        score_fix<M_CMP, true>(s0, s1, c2, slope2, dql, 1024 * t + 1039 > q0w, true);
#pragma unroll
        for (int r = 0; r < 16; ++r) { s0[r] = __builtin_amdgcn_exp2f(s0[r] - m) * inv; s1[r] = __builtin_amdgcn_exp2f(s1[r] - m) * inv; }
        bf16x8 pf[4]; pack_p(pf, s0, s1);
        { bf16x8 v0[4]; v_load4(v0, buf, voff, 0); pv_tile<64>(o, buf, pf, voff, v0); }
        if (t > 0) carry = prow[63];
#pragma unroll
        for (int j = 0; j < 2; ++j) {
            *(LAS f32x4*)(prow + 16 * j + 8 * hi) = (f32x4){s0[8 * j], s0[8 * j + 1], s0[8 * j + 2], s0[8 * j + 3]}; *(LAS f32x4*)(prow + 16 * j + 8 * hi + 4) = (f32x4){s0[8 * j + 4], s0[8 * j + 5], s0[8 * j + 6], s0[8 * j + 7]};
            *(LAS f32x4*)(prow + 32 + 16 * j + 8 * hi) = (f32x4){s1[8 * j], s1[8 * j + 1], s1[8 * j + 2], s1[8 * j + 3]}; *(LAS f32x4*)(prow + 32 + 16 * j + 8 * hi + 4) = (f32x4){s1[8 * j + 4], s1[8 * j + 5], s1[8 * j + 6], s1[8 * j + 7]}; }
        asm volatile("s_waitcnt lgkmcnt(0)" ::: "memory");
        {
            float prev = hi ? prow[31] : carry; float iv[8];
#pragma unroll
            for (int k = 0; k < 8; ++k) { const f32x4 p4 = *(const LAS f32x4*)(prow + 32 * hi + 4 * k); iv[k] = 0.5f * prev + p4[0] + p4[1] + p4[2] + 0.5f * p4[3]; prev = p4[3]; }
            LAS float* ih = (LAS float*)(lds + C_IMPH) + (t & 1) * 4096 + hh * 1024 + (32 * qs + l31) * 16 + 8 * hi;
            *(LAS f32x4*)ih = (f32x4){iv[0], iv[1], iv[2], iv[3]}; *(LAS f32x4*)(ih + 4) = (f32x4){iv[4], iv[5], iv[6], iv[7]};
        }
        if (t + 1 < nt) stage_store<64, 64>(sr, lds + ((t + 1) & 1) * CSTG, tid);
        __syncthreads();
    }
    for (int i = tid; i < 64 * (128 - 16 * nt); i += 512) { const int q = i & 63, n = 16 * nt + (i >> 6); impg[(size_t)n * S + q] = 0.f; }
    float* oc = (float*)(P.dob + DO_OC) + (size_t)(b * S + qpos) * 512 + h * 64;
#pragma unroll
    for (int blk = 0; blk < 2; ++blk)
#pragma unroll
        for (int rr = 0; rr < 4; ++rr) *(f32x4*)(oc + 32 * blk + 8 * rr + 4 * hi) = (f32x4){o[blk][4 * rr], o[blk][4 * rr + 1], o[blk][4 * rr + 2], o[blk][4 * rr + 3]};
    __syncthreads();
}
constexpr int UKSB = 528, USTG = 64 * UKSB;
DI void upproj_unit(const Ptrs& P, int rb, int j, LAS char* lds, int tid, int lane, int wid) {
    asm volatile("" : "+v"(tid), "+v"(lane));
    const int l31 = lane & 31, hi = lane >> 5; const size_t row = (size_t)rb * 256 + wid * 32 + l31;
    const int koff = pi_row(l31) * UKSB + hi * 16;
    const bf16* WQ = (const bf16*)(P.ws + WS_WUQ); const bf16* WKV = (const bf16*)(P.ws + WS_WUKV);
    bf16x8 qf[16]; int have = -1;
    u32x4 sr[4];
#define UP_TILE(i, SRC, NT) const int SRC = (j == 0) ? ((i) < 12 ? 0 : 1) : 1; const int NT = (j == 0) ? ((i) < 12 ? (i) : (i) - 12) : (i) + 2
#define UP_LOAD(i) { UP_TILE(i, s_, n_); const char* wt = (const char*)((s_ ? WKV : WQ) + (size_t)n_ * 64 * 256); _Pragma("unroll") for (int c = 0; c < 4; ++c) sr[c] = *(const u32x4*)(wt + (size_t)(tid + 512 * c) * 16); }
#define UP_STORE(buf) { _Pragma("unroll") for (int c = 0; c < 4; ++c) { const int ch = tid + 512 * c; *(LAS u32x4*)((buf) + (ch >> 5) * UKSB + (ch & 31) * 16) = sr[c]; } }
    UP_LOAD(0); UP_STORE(lds); __syncthreads();
    for (int i = 0; i < 14; ++i) {
        UP_TILE(i, src, nt);
        if (i + 1 < 14) UP_LOAD(i + 1);
        if (src != have) { const bf16* A = (const bf16*)(P.ws + (src ? WS_KVLN : WS_QLN)) + row * 256 + hi * 8;
#pragma unroll
            for (int d0 = 0; d0 < 16; ++d0) qf[d0] = *(const bf16x8*)(A + d0 * 16);
            have = src; }
        const LAS char* buf = lds + (i & 1) * USTG;
        f32x16 s0, s1;
#pragma unroll
        for (int r = 0; r < 16; ++r) { s0[r] = 0.f; s1[r] = 0.f; }
        bf16x8 f0 = *(const LAS bf16x8*)(buf + koff), f1 = *(const LAS bf16x8*)(buf + koff + 32 * UKSB);
#pragma unroll
        for (int d0 = 0; d0 < 16; ++d0) { bf16x8 n0 = f0, n1 = f1;
            if (d0 + 1 < 16) { n0 = *(const LAS bf16x8*)(buf + koff + (d0 + 1) * 32); n1 = *(const LAS bf16x8*)(buf + koff + 32 * UKSB + (d0 + 1) * 32); }
            s0 = MFMA32(f0, qf[d0], s0); s1 = MFMA32(f1, qf[d0], s1); f0 = n0; f1 = n1; }
        bf16x8 pf[4]; pack_p(pf, s0, s1);
        bf16* orow = (bf16*)(P.ws + (src ? WS_KV : WS_QRAW)) + row * (src ? 1024 : 768) + nt * 64 + 8 * hi;
        *(bf16x8*)(orow) = pf[0]; *(bf16x8*)(orow + 16) = pf[1]; *(bf16x8*)(orow + 32) = pf[2]; *(bf16x8*)(orow + 48) = pf[3];
        if (i + 1 < 14) UP_STORE(lds + ((i + 1) & 1) * USTG);
        __syncthreads();
    }
#undef UP_TILE
#undef UP_LOAD
#undef UP_STORE
}

DI void transpose_item(const float* W, int K, int N, int Npad, bf16* WT, int row_off, LAS float* scr, int item, int lane) {
    const int nblk = Npad / 32, kb = item / nblk, nb = item % nblk, k0 = 64 * kb, n0 = 32 * nb; const int nn = n0 + (lane & 31); const bool okn = nn < N;
#pragma unroll 8
    for (int i = 0; i < 32; ++i) { const int kk = 2 * i + (lane >> 5); scr[kk * 33 + (lane & 31)] = okn ? W[(size_t)(k0 + kk) * N + nn] : 0.f; }
    asm volatile("s_waitcnt lgkmcnt(0)" ::: "memory");
    const int c = lane & 7;
#pragma unroll
    for (int j = 0; j < 4; ++j) { const int n = (lane >> 3) + 8 * j; const LAS float* s = scr + (8 * c) * 33 + n;
        u32x4 o; o.x = pk2(s[0 * 33], s[1 * 33]); o.y = pk2(s[2 * 33], s[3 * 33]); o.z = pk2(s[4 * 33], s[5 * 33]); o.w = pk2(s[6 * 33], s[7 * 33]);
        *(u32x4*)(WT + (size_t)(row_off + n0 + n) * K + k0 + 8 * c) = o; }
    asm volatile("s_waitcnt lgkmcnt(0)" ::: "memory");
}
DI void wave_transpose64(const bf16* src, size_t pitch, bf16* dst_row, int lane) {
    unsigned w[32];
#pragma unroll
    for (int k = 0; k < 32; ++k) { const unsigned a = src[(size_t)(2 * k) * pitch + lane], b = src[(size_t)(2 * k + 1) * pitch + lane]; w[k] = a | (b << 16); }
#pragma unroll
    for (int k = 0; k < 8; ++k) *(u32x4*)(dst_row + 8 * k) = (u32x4){w[4 * k], w[4 * k + 1], w[4 * k + 2], w[4 * k + 3]};
}
template <bool FINAL> DI void ln_row(const float* zrow, const float* g, const float* b, bf16* xn, float* st, float* outrow, int lane) {
    f32x4 v[4]; float s = 0.f;
#pragma unroll
    for (int j = 0; j < 4; ++j) { v[j] = *(const f32x4*)(zrow + 256 * j + 4 * lane); s += (v[j].x + v[j].y) + (v[j].z + v[j].w); }
    const float mean = wave_sum(s) * (1.f / 1024.f); float s2 = 0.f;
#pragma unroll
    for (int j = 0; j < 4; ++j) { v[j] = v[j] - mean; s2 += (v[j].x * v[j].x + v[j].y * v[j].y) + (v[j].z * v[j].z + v[j].w * v[j].w); }
    const float rstd = 1.f / sqrtf(wave_sum(s2) * (1.f / 1024.f) + LN_EPS);
#pragma unroll
    for (int j = 0; j < 4; ++j) { const f32x4 gv = *(const f32x4*)(g + 256 * j + 4 * lane), bv = *(const f32x4*)(b + 256 * j + 4 * lane); const f32x4 o = v[j] * rstd * gv + bv;
        if (FINAL) *(f32x4*)(outrow + 256 * j + 4 * lane) = o; else { u32x2 w; w.x = pk2(o.x, o.y); w.y = pk2(o.z, o.w); *(u32x2*)(xn + 256 * j + 4 * lane) = w; } }
    if (!FINAL) { if (lane == 0) { st[0] = mean; st[1] = rstd; } }
}
template <bool FINAL> DI void ln_rows4(const float* z, size_t m0, size_t stride, const float* g, const float* b, bf16* xn, float* st, float* out, int lane) {
    f32x4 v[4][4]; float mean[4], rstd[4];
#pragma unroll
    for (int r = 0; r < 4; ++r)
#pragma unroll
        for (int j = 0; j < 4; ++j) v[r][j] = *(const f32x4*)(z + (m0 + r * stride) * D + 256 * j + 4 * lane);
#pragma unroll
    for (int r = 0; r < 4; ++r) { float s = 0.f;
#pragma unroll
        for (int j = 0; j < 4; ++j) s += (v[r][j].x + v[r][j].y) + (v[r][j].z + v[r][j].w);
        mean[r] = s; }
#pragma unroll
    for (int o = 1; o < 64; o <<= 1) {
#pragma unroll
        for (int r = 0; r < 4; ++r) mean[r] += __shfl_xor(mean[r], o); }
#pragma unroll
    for (int r = 0; r < 4; ++r) { mean[r] *= (1.f / 1024.f); float s2 = 0.f;
#pragma unroll
        for (int j = 0; j < 4; ++j) { v[r][j] = v[r][j] - mean[r]; s2 += (v[r][j].x * v[r][j].x + v[r][j].y * v[r][j].y) + (v[r][j].z * v[r][j].z + v[r][j].w * v[r][j].w); }
        rstd[r] = s2; }
#pragma unroll
    for (int o = 1; o < 64; o <<= 1) {
#pragma unroll
        for (int r = 0; r < 4; ++r) rstd[r] += __shfl_xor(rstd[r], o); }
#pragma unroll
    for (int r = 0; r < 4; ++r) rstd[r] = 1.f / sqrtf(rstd[r] * (1.f / 1024.f) + LN_EPS);
#pragma unroll
    for (int j = 0; j < 4; ++j) { const f32x4 gv = *(const f32x4*)(g + 256 * j + 4 * lane), bv = *(const f32x4*)(b + 256 * j + 4 * lane);
#pragma unroll
        for (int r = 0; r < 4; ++r) { const f32x4 o = v[r][j] * rstd[r] * gv + bv; const size_t row = m0 + r * stride;
            if (FINAL) *(f32x4*)(out + row * D + 256 * j + 4 * lane) = o; else { u32x2 w; w.x = pk2(o.x, o.y); w.y = pk2(o.z, o.w); *(u32x2*)(xn + row * D + 256 * j + 4 * lane) = w; } } }
    if (!FINAL) { if (lane < 4) { const int r = lane; const float mm = (r == 0) ? mean[0] : (r == 1) ? mean[1] : (r == 2) ? mean[2] : mean[3], rr = (r == 0) ? rstd[0] : (r == 1) ? rstd[1] : (r == 2) ? rstd[2] : rstd[3];
        *(f32x2*)(st + 2 * (m0 + r * stride)) = (f32x2){mm, rr}; } }
}
DI void sincos_d(double a, float& c, float& s) {
    const double TWO_PI = 6.283185307179586476925286766559; const double k = __builtin_rint(a / TWO_PI); double r = a - k * TWO_PI;
    const double r2 = r * r; double cs = 1.0, sn = r, tc = 1.0, ts = r;
#pragma unroll 1
    for (int i = 1; i <= 14; ++i) { tc = -tc * r2 / (double)((2 * i - 1) * (2 * i)); ts = -ts * r2 / (double)((2 * i) * (2 * i + 1)); cs += tc; sn += ts; }
    c = (float)cs; s = (float)sn;
}

struct Args { const float* in[32]; float* out; unsigned char* ws; int ph_lo, ph_hi; };
constexpr int NPHASE = 22;
constexpr int XB_LDS_OFF = LDS_BYTES - 128;
#ifndef REP_ATT
#define REP_ATT 1
#endif
#ifndef REP_GEMM
#define REP_GEMM 1
#endif
#ifndef REP_MISC
#define REP_MISC 1
#endif
#define RA for (int rep_ = 0; rep_ < REP_ATT; ++rep_)
#define RG for (int rep_ = 0; rep_ < REP_GEMM; ++rep_)
#define RM for (int rep_ = 0; rep_ < REP_MISC; ++rep_)

#define GEMM_PHASE(EPI, Aptr, Bptr, M_, N_, K_, ...) do { pg8::Gemm g_{(const pg8::bf16_t*)(Aptr), (const pg8::bf16_t*)(Bptr), (M_), (N_), (K_)}; pg8::StaticOrder S_; S_.init((M_), (N_), G, bid); \
    EPI E_{__VA_ARGS__}; pg8::gemm_phase<EPI, pg8::StaticOrder, true, true>(lds, g_, S_, E_); } while (0)

__global__ void __launch_bounds__(512, 2) mega_fwd(Args args) {
    extern __shared__ __attribute__((aligned(16))) unsigned char lds_raw[];
    LAS unsigned char* lds = (LAS unsigned char*)lds_raw;
    cg::grid_group grid = cg::this_grid();
    const int tid = threadIdx.x, lane = tid & 63, wid = __builtin_amdgcn_readfirstlane(tid >> 6), G = gridDim.x, bid = blockIdx.x;
    const int vcu = vcu_of(bid, G), gw = vcu * 8 + wid, NGW = G * 8;
    Ptrs P;
#pragma unroll
    for (int i = 0; i < 32; ++i) P.in[i] = args.in[i];
    P.out = args.out; P.ws = args.ws; P.dob = (unsigned char*)args.out;
    unsigned char* ws = args.ws; unsigned char* dob = P.dob;
    const int lo = args.ph_lo, hi_ph = args.ph_hi;
#define IN(k) (lo <= (k) && (k) < hi_ph)
#define SEAM(k) do { if (IN(k) && IN((k) + 1)) { if ((k) == 0) grid.sync(); else xcd_barrier(xbar); } } while (0)
    { volatile LAS unsigned* stw = (volatile LAS unsigned*)(lds + XB_LDS_OFF); if (tid == 0) { stw[0] = 0u; stw[1] = 0u; } __syncthreads(); }
    XcdBarrier xbar = xcd_barrier_post((unsigned*)(ws + WS_CTL), (volatile LAS unsigned*)(lds + XB_LDS_OFF));
    float* stats = (float*)(ws + WS_STATS);
    bf16* Hb = (bf16*)(ws + WS_H); bf16* XB = (bf16*)(ws + WS_XB);

#ifdef PROBE_SYNCS
    if (lo == 0) { for (int i_ = 0; i_ < PROBE_SYNCS; ++i_) grid.sync(); }
#endif
    if (IN(0)) RM {
        LAS float* scr = (LAS float*)(lds + wid * 16384);
        constexpr int I0 = 16 * 64, I1 = 4 * 24, I2 = 4 * 32, I3 = 32 * 2, I4 = 32 * 2, I5 = 32 * 4, I6 = 16 * 32, I7 = 16 * 128, I8 = 64 * 32, I9 = 16 * 96, I10 = 16 * 32, I11 = 16 * 128, I12 = 64 * 32;
        constexpr int NIT = I0 + I1 + I2 + I3 + I4 + I5 + I6 + I7 + I8 + I9 + I10 + I11 + I12;
        for (int it = gw; it < NIT; it += NGW) { int r = it;
            if (r < I0) { transpose_item(P.in[1], 1024, L0W, 2048, (bf16*)(ws + WS_WIN), 0, scr, r, lane); continue; } r -= I0;
            if (r < I1) { transpose_item(P.in[3], 256, 768, 768, (bf16*)(ws + WS_WUQ), 0, scr, r, lane); continue; } r -= I1;
            if (r < I2) { transpose_item(P.in[5], 256, 1024, 1024, (bf16*)(ws + WS_WUKV), 0, scr, r, lane); continue; } r -= I2;
            if (r < I3) { transpose_item(P.in[7], 2048, 64, 64, (bf16*)(ws + WS_W1), 0, scr, r, lane); continue; } r -= I3;
            if (r < I4) { transpose_item(P.in[10], 2048, 64, 64, (bf16*)(ws + WS_W1), 64, scr, r, lane); continue; } r -= I4;
            if (r < I5) { transpose_item(P.in[7], 2048, 0, 128, (bf16*)(ws + WS_W1), 128, scr, r, lane); continue; } r -= I5;
            if (r < I6) { transpose_item(P.in[12], 1024, 1024, 1024, (bf16*)(ws + WS_WOUT), 0, scr, r, lane); continue; } r -= I6;
            if (r < I7) { transpose_item(P.in[15], 1024, 4096, 4096, (bf16*)(ws + WS_WUP0), 0, scr, r, lane); continue; } r -= I7;
            if (r < I8) { transpose_item(P.in[16], 4096, 1024, 1024, (bf16*)(ws + WS_WDN0), 0, scr, r, lane); continue; } r -= I8;
            if (r < I9) { transpose_item(P.in[19], 1024, 3072, 3072, (bf16*)(ws + WS_WQKV), 0, scr, r, lane); continue; } r -= I9;
            if (r < I10) { transpose_item(P.in[25], 1024, 1024, 1024, (bf16*)(ws + WS_WO), 0, scr, r, lane); continue; } r -= I10;
            if (r < I11) { transpose_item(P.in[28], 1024, 4096, 4096, (bf16*)(ws + WS_WUP1), 0, scr, r, lane); continue; } r -= I11;
            transpose_item(P.in[29], 4096, 1024, 1024, (bf16*)(ws + WS_WDN1), 0, scr, r, lane);
        }
        for (int m = gw; m < T; m += 4 * NGW) { f32x4 v[4][4];
#pragma unroll
            for (int r = 0; r < 4; ++r)
#pragma unroll
                for (int j = 0; j < 4; ++j) v[r][j] = *(const f32x4*)(P.in[0] + (size_t)(m + r * NGW) * D + 256 * j + 4 * lane);
#pragma unroll
            for (int r = 0; r < 4; ++r)
#pragma unroll
                for (int j = 0; j < 4; ++j) { u32x2 w; w.x = pk2(v[r][j].x, v[r][j].y); w.y = pk2(v[r][j].z, v[r][j].w); *(u32x2*)(XB + (size_t)(m + r * NGW) * D + 256 * j + 4 * lane) = w; } }
        { const float INV[16] = {1.f, 0.562341332f, 0.316227764f, 0.177827939f, 0.100000001f, 0.0562341288f, 0.0316227786f, 0.0177827943f, 0.00999999978f, 0.00562341325f, 0.00316227786f, 0.00177827943f, 0.00100000005f, 0.000562341302f, 0.000316227786f, 0.00017782794f};
          f32x2* rope = (f32x2*)(dob + DO_ROPE);
          for (int idx = bid * 512 + tid; idx < S * 16; idx += G * 512) { const int i = idx & 15, t = idx >> 4; float inv = INV[0];
#pragma unroll
              for (int k = 1; k < 16; ++k) inv = (i == k) ? INV[k] : inv;
              const float ang = (float)t * inv; float c, s; sincos_d((double)ang, c, s); rope[idx] = (f32x2){c, s}; } }
    }
    SEAM(0);
    if (IN(1)) RG GEMM_PHASE(pg8::EpiB16<0>, XB, ws + WS_WIN, T, HW, D, Hb, HW);
    SEAM(1);
    if (IN(2)) RM {
        const f32x2* rope = (const f32x2*)(dob + DO_ROPE);
        LAS unsigned* knl = (LAS unsigned*)lds;
        if (tid < 16) knl[tid] = 0u;
        __syncthreads();
        for (int row = gw; row < T; row += NGW) { const bf16* hr = Hb + (size_t)row * HW; const int t = row & (S - 1);
            { const float a0 = bf2f(hr[C_KS + lane]), a1 = bf2f(hr[C_KS + 64 + lane]), b0 = bf2f(hr[C_KW + lane]), b1 = bf2f(hr[C_KW + 64 + lane]);
              const float n0 = wave_sum(a0 * a0), n1 = wave_sum(a1 * a1), n2 = wave_sum(b0 * b0), n3 = wave_sum(b1 * b1); const int bb = row >> 13;
              if (lane == 0) { __hip_atomic_fetch_max(&knl[bb * 2], __builtin_bit_cast(unsigned, n0), __ATOMIC_RELAXED, __HIP_MEMORY_SCOPE_WORKGROUP); __hip_atomic_fetch_max(&knl[bb * 2 + 1], __builtin_bit_cast(unsigned, n1), __ATOMIC_RELAXED, __HIP_MEMORY_SCOPE_WORKGROUP); __hip_atomic_fetch_max(&knl[8 + bb * 2], __builtin_bit_cast(unsigned, n2), __ATOMIC_RELAXED, __HIP_MEMORY_SCOPE_WORKGROUP); __hip_atomic_fetch_max(&knl[8 + bb * 2 + 1], __builtin_bit_cast(unsigned, n3), __ATOMIC_RELAXED, __HIP_MEMORY_SCOPE_WORKGROUP); } }
#pragma unroll
            for (int which = 0; which < 2; ++which) { const u32x2 w = *(const u32x2*)(hr + which * 256 + 4 * lane); const float x0 = bf2f(w.x & 0xffffu), x1 = bf2f(w.x >> 16), x2 = bf2f(w.y & 0xffffu), x3 = bf2f(w.y >> 16);
                const float ss = wave_sum(x0 * x0 + x1 * x1 + x2 * x2 + x3 * x3); const float r = 1.f / sqrtf(ss * (1.f / 256.f) + RMS_EPS);
                const f32x4 gn = *(const f32x4*)(P.in[which ? 4 : 2] + 4 * lane); u32x2 o; o.x = pk2(x0 * r * gn.x, x1 * r * gn.y); o.y = pk2(x2 * r * gn.z, x3 * r * gn.w);
                *(u32x2*)((bf16*)(ws + (which ? WS_KVLN : WS_QLN)) + (size_t)row * 256 + 4 * lane) = o; }
            if (lane < 16) { const float x1 = bf2f(hr[C_KROPE + lane]), x2 = bf2f(hr[C_KROPE + 16 + lane]); const f32x2 cs = rope[t * 16 + lane]; bf16* kp = (bf16*)(dob + DO_KPE) + (size_t)row * 32;
                kp[lane] = (bf16)f2bf(x1 * cs.x - x2 * cs.y); kp[16 + lane] = (bf16)f2bf(x1 * cs.y + x2 * cs.x); }
            if (lane < 24) { const float v = bf2f(hr[C_GATE + lane]); ((float*)(dob + DO_GATE))[(size_t)row * 24 + lane] = 1.f / (1.f + __expf(-v)); }
        }
        for (int r = gw; r < 8192; r += NGW) { const int kv = r >> 12, rr = r & 4095, g = rr & 1, bi = rr >> 1, b = bi >> 9, i = bi & 511; bf16* dst = (bf16*)(ws + WS_ACMP) + (size_t)r * 2048;
            const float* pos = P.in[kv ? 9 : 6]; const int cb = (kv ? C_VC : C_KC) + g * 64;
#pragma unroll
            for (int it = 0; it < 8; ++it) { const int l = it * 4 + (lane >> 4), d4 = (lane & 15) * 4; u32x2 o = {0u, 0u};
                if (i < 511) { const u32x2 w = *(const u32x2*)(Hb + (size_t)(b * S + 16 * i + l) * HW + cb + d4); const f32x4 pv = *(const f32x4*)(pos + l * 64 + d4);
                    o.x = pk2(bf2f(w.x & 0xffffu) + pv.x, bf2f(w.x >> 16) + pv.y); o.y = pk2(bf2f(w.y & 0xffffu) + pv.z, bf2f(w.y >> 16) + pv.w); }
                *(u32x2*)(dst + l * 64 + d4) = o; } }
        for (int it = gw; it < 2048; it += NGW) { const int which = it >> 10, r = it & 1023, bg = r >> 7, tb = r & 127, b = bg >> 1, g = bg & 1;
            wave_transpose64(Hb + (size_t)(b * S + tb * 64) * HW + (which ? C_VW : C_VS) + g * 64, HW, (bf16*)(ws + (which ? WS_VTW : WS_VTS)) + (size_t)(bg * 64 + lane) * S + tb * 64, lane); }
        __syncthreads();
        if (tid < 16) atomicMax((unsigned*)(ws + WS_CTL) + KN_WORD + 64 + tid, knl[tid]);
    }
    SEAM(2);
    if (IN(3)) {
        GEMM_PHASE(pg8::EpiF32<3>, ws + WS_ACMP, ws + WS_W1, 8192, 256, 2048, (float*)(dob + DO_CH), 256);
        { unsigned* qc = (unsigned*)(ws + WS_CTL) + 3703; volatile LAS int* qs = (volatile LAS int*)(lds + LDS_BYTES - 256);
          for (;;) { __syncthreads(); if (tid == 0) *qs = (int)atomicAdd(qc, 1u); __syncthreads(); const int e = *qs; if (e >= 256) break;
              upproj_unit(P, e >> 1, e & 1, (LAS char*)lds, tid, lane, wid); } }
    }
    SEAM(3);
    if (IN(4)) RM {
        for (int r = gw; r < 8192; r += NGW) { const int kv = r >> 12, rr = r & 4095, g = rr & 1, bi = rr >> 1, b = bi >> 9, i = bi & 511;
            const float* ch = (const float*)(dob + DO_CH) + (size_t)r * 256 + kv * 64; const float* w2 = P.in[kv ? 11 : 8]; float acc = 0.f;
#pragma unroll 8
            for (int c = 0; c < 64; ++c) acc = __builtin_fmaf(ch[c], w2[c * 64 + lane], acc);
            if (kv == 0) ((bf16*)(dob + DO_KC))[(size_t)((b * 2 + g) * 512 + i) * 64 + lane] = (bf16)f2bf(acc);
            else ((bf16*)(dob + DO_VCT))[(size_t)((b * 2 + g) * 64 + lane) * 512 + i] = (bf16)f2bf(acc); }
        for (int it = gw; it < 4096; it += NGW) { const int bh = it >> 7, tb = it & 127, b = bh >> 3, h = bh & 7;
            wave_transpose64((const bf16*)(ws + WS_KV) + (size_t)(b * S + tb * 64) * 1024 + h * 128 + 64, 1024, (bf16*)(ws + WS_QLN) + (size_t)(bh * 64 + lane) * S + tb * 64, lane); }
    }
    SEAM(4);
    if (IN(5)) RA {
        for (int p = vcu; p < 512; p += G) { const int bh = p >> 4, s = p & 15; mla_unit(P, bh >> 3, bh & 7, 31 - s, (LAS char*)lds, tid, lane, wid); mla_unit(P, bh >> 3, bh & 7, s, (LAS char*)lds, tid, lane, wid); }
        for (int u = vcu; u < 1024; u += G) { const int bg = u & 7, qblk = u >> 3; cmp_unit(P, bg >> 1, bg & 1, qblk, (LAS char*)lds, tid, lane, wid); }
    }
    SEAM(5);
    if (IN(6)) RM {
        const float* imp = (const float*)(ws + WS_ACMP); unsigned* selm = (unsigned*)(dob + DO_SELM);
        for (int it = gw; it < NB * 2 * S / 64; it += NGW) { const int bg = it >> 7, q = ((it & 127) << 6) + lane, cur = q >> 6; const float* ip = imp + (size_t)(bg * 128) * S + q;
            float w[128];
#pragma unroll
            for (int n = 0; n < 128; ++n) { const float v = ip[(size_t)n * S]; w[n] = (n <= cur) ? v + ((n == 0 || n == cur || n == cur - 1) ? 1000.f : 0.f) : NEGF; }
            unsigned m0 = 0u, m1 = 0u, m2 = 0u, m3 = 0u;
#pragma unroll 1
            for (int r = 0; r < 16; ++r) {
                float a = mx3(w[0], w[1], w[2]), c = mx3(w[3], w[4], w[5]);
#pragma unroll
                for (int n = 6; n < 126; n += 4) { a = mx3(a, w[n], w[n + 1]); c = mx3(c, w[n + 2], w[n + 3]); }
                const float mxv = mx3(a, c, fmaxf(w[126], w[127]));
                int idx = 0;
#pragma unroll
                for (int n = 127; n >= 0; --n) idx = (w[n] == mxv) ? n : idx;
#pragma unroll
                for (int n = 0; n < 128; ++n) w[n] = (n == idx) ? -3.0e38f : w[n];
                const unsigned bit = (mxv > -1e29f) ? (1u << (idx & 31)) : 0u; const int wsel = idx >> 5;
                m0 |= (wsel == 0) ? bit : 0u; m1 |= (wsel == 1) ? bit : 0u; m2 |= (wsel == 2) ? bit : 0u; m3 |= (wsel == 3) ? bit : 0u;
            }
            *(u32x4*)(selm + ((size_t)bg * S + q) * 4) = (u32x4){m0, m1, m2, m3}; }
    }
    SEAM(6);
    if (IN(7)) {
        unsigned* qc = (unsigned*)(ws + WS_CTL) + 3700; volatile LAS int* qs = (volatile LAS int*)(lds + LDS_BYTES - 256); int e = vcu;
        while (e < 1024) { int nx = 0; if (tid == 0) nx = 256 + (int)atomicAdd(qc, 1u);
            const int h = 7 - (e >> 7), b = (e >> 5) & 3, qb = 31 - (e & 31);
            nsa_sw_unit(P, b, h, qb, (LAS char*)lds, tid, lane, wid);
            __syncthreads(); if (tid == 0) *qs = nx; __syncthreads(); e = *qs; }
    }
    SEAM(7);
    if (IN(8)) RG GEMM_PHASE(pg8::EpiResid<0>, XB, ws + WS_WOUT, T, D, D, P.in[0], nullptr, nullptr, nullptr, P.out, ALPHA);
    SEAM(8);
    if (IN(9)) RM { for (int m = gw; m < T; m += 4 * NGW) ln_rows4<false>(P.out, (size_t)m, (size_t)NGW, P.in[13], P.in[14], XB, stats, nullptr, lane); }
    SEAM(9);
    if (IN(10)) RG GEMM_PHASE(pg8::EpiB16<2>, XB, ws + WS_WUP0, T, FF, D, (pg8::bf16_t*)(ws + WS_HID), FF);
    SEAM(10);
    if (IN(11)) RG GEMM_PHASE(pg8::EpiResid<1>, ws + WS_HID, ws + WS_WDN0, T, D, FF, P.out, stats, P.in[13], P.in[14], (float*)(ws + WS_H), ALPHA);
    SEAM(11);
    if (IN(12)) RM { for (int m = gw; m < T; m += 4 * NGW) ln_rows4<false>((const float*)(ws + WS_H), (size_t)m, (size_t)NGW, P.in[17], P.in[18], XB, stats + 2 * (size_t)T, nullptr, lane); }
    SEAM(12);
    if (IN(13)) RG GEMM_PHASE(pg8::EpiB16<0>, XB, ws + WS_WQKV, T, 3072, D, (pg8::bf16_t*)(ws + WS_QKV), 3072);
    SEAM(13);
    if (IN(14)) RM { for (int it = gw; it < 8192; it += NGW) { const int half = it & 1, r = it >> 1, bh = r >> 7, tb = r & 127, b = bh >> 3, h = bh & 7;
            wave_transpose64((const bf16*)(ws + WS_QKV) + (size_t)(b * S + tb * 64) * 3072 + 2048 + h * 128 + half * 64, 3072, (bf16*)(ws + WS_VTD) + (size_t)(bh * 128 + half * 64 + lane) * S + tb * 64, lane); }
        for (int it = gw; it < 8192; it += NGW) { const int bhj = it >> 7, tb = it & 127, b = bhj >> 4, h = (bhj >> 1) & 7, j = bhj & 1;
            const bf16* kr = (const bf16*)(ws + WS_QKV) + (size_t)(b * S + tb * 64 + lane) * 3072 + 1024 + h * 128 + j * 64; float ss = 0.f;
#pragma unroll
            for (int c = 0; c < 8; ++c) { const u32x4 w = *(const u32x4*)(kr + 8 * c);
#pragma unroll
                for (int e = 0; e < 4; ++e) { const float x0 = bf2f(w[e] & 0xffffu), x1 = bf2f(w[e] >> 16); ss += x0 * x0 + x1 * x1; } }
#pragma unroll
            for (int o = 1; o < 64; o <<= 1) ss = fmaxf(ss, __shfl_xor(ss, o));
            if (lane == 0) atomicMax((unsigned*)(ws + WS_CTL) + KN_WORD + bhj, __builtin_bit_cast(unsigned, ss)); }
    }
    SEAM(14);
    if (IN(15)) {
        unsigned* qc = (unsigned*)(ws + WS_CTL) + 3701; volatile LAS int* qs = (volatile LAS int*)(lds + LDS_BYTES - 256); int e = vcu;
        while (e < 2048) { int nx = 0; if (tid == 0) nx = 256 + (int)atomicAdd(qc, 1u);
            const int h = 7 - (e >> 8), bj = (e >> 5) & 7, b = bj >> 1, j = bj & 1, qb = 31 - (e & 31);
            diff_unit(P, b, h, j, qb, (LAS char*)lds, tid, lane, wid);
            __syncthreads(); if (tid == 0) *qs = nx; __syncthreads(); e = *qs; }
    }
    SEAM(15);
    if (IN(16)) RM {
        const float a1 = wave_sum(P.in[20][lane] * P.in[21][lane]), a2 = wave_sum(P.in[22][lane] * P.in[23][lane]); const float lam = __expf(a1) - __expf(a2) + LAM_INIT;
        const bf16* OD = (const bf16*)dob; const int hh = lane >> 3, e0 = (lane & 7) * 16;
        for (int m0 = gw; m0 < T; m0 += 4 * NGW) { u32x4 w1[4][2], w2[4][2];
#pragma unroll
            for (int r = 0; r < 4; ++r) { const bf16* o1 = OD + (size_t)(m0 + r * NGW) * 2048 + hh * 256 + e0;
#pragma unroll
                for (int c = 0; c < 2; ++c) { w1[r][c] = *(const u32x4*)(o1 + 8 * c); w2[r][c] = *(const u32x4*)(o1 + 128 + 8 * c); } }
#pragma unroll
            for (int r = 0; r < 4; ++r) { const int m = m0 + r * NGW; float v[16]; float ss = 0.f;
#pragma unroll
                for (int c = 0; c < 2; ++c)
#pragma unroll
                    for (int e = 0; e < 4; ++e) { v[8 * c + 2 * e] = bf2f(w1[r][c][e] & 0xffffu) - lam * bf2f(w2[r][c][e] & 0xffffu); v[8 * c + 2 * e + 1] = bf2f(w1[r][c][e] >> 16) - lam * bf2f(w2[r][c][e] >> 16); }
#pragma unroll
                for (int e = 0; e < 16; ++e) ss += v[e] * v[e];
                ss += __shfl_xor(ss, 1); ss += __shfl_xor(ss, 2); ss += __shfl_xor(ss, 4);
                const float rr = (1.f - LAM_INIT) / sqrtf(ss * (1.f / 128.f) + RMS_EPS); const float* sg = P.in[24] + e0; bf16* dst = XB + (size_t)m * D + hh * 128 + e0;
#pragma unroll
                for (int c = 0; c < 2; ++c) { u32x4 w;
#pragma unroll
                    for (int e = 0; e < 4; ++e) w[e] = pk2(v[8 * c + 2 * e] * rr * sg[8 * c + 2 * e], v[8 * c + 2 * e + 1] * rr * sg[8 * c + 2 * e + 1]);
                    *(u32x4*)(dst + 8 * c) = w; } } }
    }
    SEAM(16);
    if (IN(17)) RG GEMM_PHASE(pg8::EpiResid<1>, XB, ws + WS_WO, T, D, D, (const float*)(ws + WS_H), stats + 2 * (size_t)T, P.in[17], P.in[18], P.out, ALPHA);
    SEAM(17);
    if (IN(18)) RM { for (int m = gw; m < T; m += 4 * NGW) ln_rows4<false>(P.out, (size_t)m, (size_t)NGW, P.in[26], P.in[27], XB, stats + 4 * (size_t)T, nullptr, lane); }
    SEAM(18);
    if (IN(19)) RG GEMM_PHASE(pg8::EpiB16<2>, XB, ws + WS_WUP1, T, FF, D, (pg8::bf16_t*)(ws + WS_HID), FF);
    SEAM(19);
    if (IN(20)) RG GEMM_PHASE(pg8::EpiResid<1>, ws + WS_HID, ws + WS_WDN1, T, D, FF, P.out, stats + 2 * (size_t)(2 * T), P.in[26], P.in[27], (float*)(ws + WS_H), ALPHA);
    SEAM(20);
    if (IN(21)) RM { for (int m = gw; m < T; m += 4 * NGW) ln_rows4<true>((const float*)(ws + WS_H), (size_t)m, (size_t)NGW, P.in[30], P.in[31], nullptr, nullptr, P.out, lane); }
#undef IN
#undef SEAM
}

extern "C" void kernel_launch(void* const* d_in, const int* in_sizes, int n_in, void* d_out, int out_size, void* d_ws, size_t ws_size, hipStream_t stream) {
    static int grid = 0;
    if (grid == 0) {
        if (n_in != 32 || out_size != T * D || ws_size < WS_CTL + 16384) { fprintf(stderr, "kernel_launch: unexpected shapes (n_in %d out %d ws %zu)\n", n_in, out_size, ws_size); grid = -1; return; }
        int dev = 0, cus = 0, per_cu = 0;
        hipGetDevice(&dev); hipDeviceGetAttribute(&cus, hipDeviceAttributeMultiprocessorCount, dev);
        hipFuncSetAttribute((const void*)mega_fwd, hipFuncAttributeMaxDynamicSharedMemorySize, LDS_BYTES);
        hipOccupancyMaxActiveBlocksPerMultiprocessor(&per_cu, (const void*)mega_fwd, 512, LDS_BYTES);
        if (per_cu < 1) { fprintf(stderr, "kernel_launch: occupancy query says %d blocks per CU\n", per_cu); per_cu = 1; }
        (void)hipGetLastError();
        grid = cus * per_cu;
        if (grid > 256) grid = 256;
        if (grid < 256) { fprintf(stderr, "kernel_launch: only %d co-resident workgroups; this kernel needs 256\n", grid); grid = -1; return; }
    }
    if (grid < 0) return;
    if (hipMemsetAsync((char*)d_ws + WS_CTL, 0, 16384, stream) != hipSuccess) { fprintf(stderr, "kernel_launch: memset failed\n"); return; }
    Args a{};
    for (int i = 0; i < 32; ++i) a.in[i] = (const float*)d_in[i];
    a.out = (float*)d_out; a.ws = (unsigned char*)d_ws;
#ifdef PROBE_SEQ
    static const int seq[][2] = PROBE_SEQ;
    for (unsigned si = 0; si < sizeof(seq) / sizeof(seq[0]); ++si) { const int ph = si; a.ph_lo = seq[si][0]; a.ph_hi = seq[si][1]; void* kargs[] = {&a}; if (si) (void)hipMemsetAsync((char*)d_ws + WS_CTL, 0, 16384, stream);
        hipError_t e = hipLaunchCooperativeKernel((const void*)mega_fwd, dim3(grid), dim3(512), kargs, LDS_BYTES, stream);
        if (e != hipSuccess) { fprintf(stderr, "launch phase %d failed: %s\n", ph, hipGetErrorString(e)); break; } }
#else
    a.ph_lo = 0; a.ph_hi = NPHASE; void* kargs[] = {&a};
    hipError_t e = hipLaunchCooperativeKernel((const void*)mega_fwd, dim3(grid), dim3(512), kargs, LDS_BYTES, stream);
    if (e != hipSuccess) fprintf(stderr, "cooperative launch failed: %s (grid %d)\n", hipGetErrorString(e), grid);
#endif
}
```

```cpp
#include <hip/hip_runtime.h>
#include <hip/hip_cooperative_groups.h>
#include <cstdio>
#include <cstdint>
namespace cg = cooperative_groups;
namespace pg8 {
#define PG8_LAS __attribute__((address_space(3)))
typedef unsigned short bf16_t;
typedef short bf16x8 __attribute__((ext_vector_type(8)));
typedef float f32x4 __attribute__((ext_vector_type(4)));
typedef unsigned u32x4 __attribute__((ext_vector_type(4)));
constexpr int BM = 256, BK = 64, HALF = 128, HTB = HALF * BK * 2  , STAGE_BYTES = 8 * HTB, NXCD = 8, WGM = 8;

__host__ __device__ __forceinline__ int lds_byte(int r, int c) { const int st = (r >> 4) * 2 + (c >> 5), rr = r & 15, cc = c & 31, ob = rr * 64 + cc * 2; return st * 1024 + (ob ^ (((ob >> 9) & 1) << 5)); }
__host__ __device__ __forceinline__ void stage_rc(int b, int& R, int& C) { const int st = b / 1024, sb = b % 1024, swz = sb ^ (((sb >> 9) & 1) << 5); R = (st >> 1) * 16 + swz / 64; C = (st & 1) * 32 + (swz % 64) / 2; }
__host__ __device__ __forceinline__ int perm32(int rho) { const int n = rho >> 4, i = rho & 15; return 8 * (i >> 2) + 4 * n + (i & 3); }

struct Unit { int pm, pn; };
struct Gemm { const bf16_t* A; const bf16_t* Bt; int M, N, K; };

struct StaticOrder {
    int nM, nN, nwg, G, c;
    __host__ __device__ void init(int M, int N, int G_, int c_) { nM = M / BM; nN = N / BM; nwg = nM * nN; G = G_; c = c_; }
    __host__ __device__ bool next(int i, Unit& u) const {
        const long L = (long)i * G + c; if (L >= nwg) return false;
        int wgid = (int)L; { const int q = nwg / NXCD, r = nwg % NXCD, xcd = wgid % NXCD, off = wgid / NXCD; wgid = (xcd < r ? xcd * (q + 1) : r * (q + 1) + (xcd - r) * q) + off; }
        const int nig = WGM * nN, gid = wgid / nig, fm = gid * WGM, gsz = (nM - fm) < WGM ? (nM - fm) : WGM;
        u.pm = fm + ((wgid % nig) % gsz); u.pn = (wgid % nig) / gsz; return true;
    }
    __device__ __forceinline__ void a_ready(const Unit&) const {}
    __device__ __forceinline__ void done(const Unit&) const {}
};

typedef float f32x2 __attribute__((ext_vector_type(2)));
typedef __bf16 bf16x2_t __attribute__((ext_vector_type(2)));
__device__ __forceinline__ unsigned cvt_pk_bf16(float lo, float hi) { f32x2 v = {lo, hi}; bf16x2_t b = __builtin_convertvector(v, bf16x2_t); return __builtin_bit_cast(unsigned, b); }
__device__ __forceinline__ float act_apply(float v, int ACT) {
    if (ACT == 2) { const float r = v > 0.f ? v : 0.f; return r * r; }
    if (ACT == 3) { const float u = 0.7978845608028654f * (v + 0.044715f * v * v * v); const float e = __builtin_amdgcn_exp2f(u * 2.8853900817779268f); const float th = 1.f - 2.f * __builtin_amdgcn_rcpf(e + 1.f); return 0.5f * v * (1.f + th); }
    return v;
}
template <int ACT> struct EpiB16 {
    static constexpr bool PERM = true, AFTER_DRAIN = false;
    bf16_t* O; int ldc;
    __device__ __forceinline__ void operator()(const f32x4 (&acc)[2][2][4][2], const Unit& u, int wr, int wc, int fr, int fq) const {
        const int row0 = u.pm * BM + wr * 64 + fr; const int col0 = u.pn * BM + wc * 32 + 8 * fq;
#pragma unroll
        for (int ai = 0; ai < 2; ++ai)
#pragma unroll
            for (int m = 0; m < 4; ++m) { bf16_t* rowp = O + (size_t)(row0 + ai * HALF + m * 16) * ldc + col0;
#pragma unroll
                for (int bj = 0; bj < 2; ++bj) { f32x4 v0 = acc[ai][bj][m][0], v1 = acc[ai][bj][m][1];
                    if (ACT != 0) {
#pragma unroll
                        for (int e = 0; e < 4; ++e) { v0[e] = act_apply(v0[e], ACT); v1[e] = act_apply(v1[e], ACT); } }
                    u32x4 w; w.x = cvt_pk_bf16(v0[0], v0[1]); w.y = cvt_pk_bf16(v0[2], v0[3]); w.z = cvt_pk_bf16(v1[0], v1[1]); w.w = cvt_pk_bf16(v1[2], v1[3]);
                    *(u32x4*)(rowp + bj * HALF) = w; } }
    }
};
template <int ACT> struct EpiF32 {
    static constexpr bool PERM = false, AFTER_DRAIN = false;
    float* O; int ldc;
    __device__ __forceinline__ void operator()(const f32x4 (&acc)[2][2][4][2], const Unit& u, int wr, int wc, int fr, int fq) const {
        const int row0 = u.pm * BM + wr * 64 + fr; const int col0 = u.pn * BM + wc * 32 + 4 * fq;
#pragma unroll
        for (int ai = 0; ai < 2; ++ai)
#pragma unroll
            for (int m = 0; m < 4; ++m) { float* rowp = O + (size_t)(row0 + ai * HALF + m * 16) * ldc + col0;
#pragma unroll
                for (int bj = 0; bj < 2; ++bj)
#pragma unroll
                    for (int n = 0; n < 2; ++n) { f32x4 v = acc[ai][bj][m][n];
#pragma unroll
                        for (int e = 0; e < 4; ++e) v[e] = act_apply(v[e], ACT);
                        *(f32x4*)(rowp + bj * HALF + n * 16) = v; } }
    }
};
template <int MODE> struct EpiResid {
    static constexpr bool PERM = false, AFTER_DRAIN = false;
    const float* base; const float* stats; const float* g; const float* b; float* out; float alpha;
    __device__ __forceinline__ void operator()(const f32x4 (&acc)[2][2][4][2], const Unit& u, int wr, int wc, int fr, int fq) const {
        const int row0 = u.pm * BM + wr * 64 + fr; const int col0 = u.pn * BM + wc * 32 + 4 * fq;
#pragma unroll
        for (int ai = 0; ai < 2; ++ai)
#pragma unroll
            for (int m = 0; m < 4; ++m) { const int r = row0 + ai * HALF + m * 16; const size_t off = (size_t)r * 1024 + col0;
                float mean = 0.f, rstd = 1.f; if (MODE == 1) { const f32x2 st = *(const f32x2*)(stats + 2 * (size_t)r); mean = st.x; rstd = st.y; }
#pragma unroll
                for (int bj = 0; bj < 2; ++bj)
#pragma unroll
                    for (int n = 0; n < 2; ++n) { f32x4 bs = *(const f32x4*)(base + off + bj * HALF + n * 16);
                        if (MODE == 1) { const f32x4 gv = *(const f32x4*)(g + col0 + bj * HALF + n * 16), bv = *(const f32x4*)(b + col0 + bj * HALF + n * 16); bs = (bs - mean) * rstd * gv + bv; }
                        *(f32x4*)(out + off + bj * HALF + n * 16) = bs * alpha + acc[ai][bj][m][n]; }
                asm volatile("" ::: "memory"); }
    }
};

template <class Epi, class Sched, bool ALIGN_EPI = false, bool SP2 = false>
__device__ __forceinline__ void gemm_phase(PG8_LAS unsigned char* lds, const Gemm g, const Sched& S, const Epi& E) {
    const int tid = threadIdx.x, wid = __builtin_amdgcn_readfirstlane(tid >> 6), lane = tid & 63, wr = wid >> 2, wc = wid & 3, fr = lane & 15, fq = lane >> 4;
    const int K = g.K, nt = K / BK;
    unsigned voffA[2], voffB[2];
#pragma unroll
    for (int i = 0; i < 2; ++i) { int R, C; stage_rc(tid * 16 + i * 8192, R, C); const int Rb = Epi::PERM ? ((R & ~31) + perm32(R & 31)) : R;
        voffA[i] = (unsigned)(R * K + C) * 2u; voffB[i] = (unsigned)(Rb * K + C) * 2u; }
    const size_t kstep = (size_t)(BK * 2);
    const size_t hstep = (size_t)HALF * K * 2;
    const size_t tstep = 2 * hstep;
    const unsigned ldsw = (unsigned)wid * 1024u;
    const int aoff = lds_byte(wr * 64 + fr, fq * 8), boff = lds_byte(wc * 32 + fr, fq * 8);
#define PG8_SA(b, h) (((b) * 2 + (h)) * HTB)
#define PG8_SB(b, h) ((4 + (b) * 2 + (h)) * HTB)
#define PG8_STAGE(bufoff, gbase, voff) do { _Pragma("unroll") for (int _i = 0; _i < 2; ++_i) \
        __builtin_amdgcn_global_load_lds((const unsigned*)((const char*)(gbase) + (voff)[_i]), (PG8_LAS unsigned*)(lds + (bufoff) + ldsw + _i * 8192), 16, 0, 0); } while (0)
#define PG8_LDA(dst, b, h) do { _Pragma("unroll") for (int m = 0; m < 4; ++m) _Pragma("unroll") for (int k = 0; k < 2; ++k) dst[m][k] = *(const PG8_LAS bf16x8*)(lds + PG8_SA(b, h) + aoff + m * 2048 + k * 1024); } while (0)
#define PG8_LDB(dst, b, h) do { _Pragma("unroll") for (int n = 0; n < 2; ++n) _Pragma("unroll") for (int k = 0; k < 2; ++k) dst[n][k] = *(const PG8_LAS bf16x8*)(lds + PG8_SB(b, h) + boff + n * 2048 + k * 1024); } while (0)
#define PG8_MMA(ai, bj, At, Bt) do { __builtin_amdgcn_s_setprio(1); _Pragma("unroll") for (int m = 0; m < 4; ++m) _Pragma("unroll") for (int n = 0; n < 2; ++n) _Pragma("unroll") for (int k = 0; k < 2; ++k) \
        acc[ai][bj][m][n] = __builtin_amdgcn_mfma_f32_16x16x32_bf16(Bt[n][k], At[m][k], acc[ai][bj][m][n], 0, 0, 0); __builtin_amdgcn_s_setprio(0); } while (0)
#define PG8_WAIT_V(n) asm volatile("s_waitcnt vmcnt(" #n ")" ::: "memory")
#define PG8_WAIT_L(n) asm volatile("s_waitcnt lgkmcnt(" #n ")" ::: "memory")
#define PG8_BAR __builtin_amdgcn_s_barrier()
#define PG8_SCHED __builtin_amdgcn_sched_barrier(0)
    Unit cur, nxt; int ui = 0;
    if (!S.next(0, cur)) return;
    f32x4 acc[2][2][4][2];
#pragma unroll
    for (int a = 0; a < 2; ++a)
#pragma unroll
        for (int b = 0; b < 2; ++b)
#pragma unroll
            for (int m = 0; m < 4; ++m)
#pragma unroll
                for (int n = 0; n < 2; ++n) acc[a][b][m][n] = (f32x4){0.f, 0.f, 0.f, 0.f};
    bf16x8 At[4][2], B0[2][2], B1[2][2];
    const char* cA = (const char*)g.A + (size_t)cur.pm * tstep; const char* cB = (const char*)g.Bt + (size_t)cur.pn * tstep;
    S.a_ready(cur);
    if constexpr (SP2) {
        PG8_STAGE(PG8_SB(0, 0), cB, voffB); PG8_STAGE(PG8_SB(0, 1), cB + hstep, voffB); PG8_STAGE(PG8_SA(0, 0), cA, voffA); PG8_STAGE(PG8_SA(0, 1), cA + hstep, voffA);
        if (wr == 1) PG8_BAR;
        PG8_WAIT_V(2); PG8_BAR;
        PG8_STAGE(PG8_SB(1, 0), cB + kstep, voffB); PG8_STAGE(PG8_SA(1, 0), cA + kstep, voffA); PG8_STAGE(PG8_SB(1, 1), cB + hstep + kstep, voffB);
        PG8_WAIT_V(6); PG8_BAR;
    } else {
        PG8_STAGE(PG8_SB(0, 0), cB, voffB); PG8_STAGE(PG8_SA(0, 0), cA, voffA); PG8_STAGE(PG8_SB(0, 1), cB + hstep, voffB); PG8_STAGE(PG8_SA(0, 1), cA + hstep, voffA);
        if (wr == 1) PG8_BAR;
        PG8_WAIT_V(4); PG8_BAR;
        PG8_STAGE(PG8_SB(1, 0), cB + kstep, voffB); PG8_STAGE(PG8_SA(1, 0), cA + kstep, voffA); PG8_STAGE(PG8_SB(1, 1), cB + hstep + kstep, voffB);
        PG8_WAIT_V(6); PG8_BAR;
    }
    for (;;) {
        const bool has_next = S.next(ui + 1, nxt);
        const char* nA = has_next ? (const char*)g.A + (size_t)nxt.pm * tstep : cA; const char* nB = has_next ? (const char*)g.Bt + (size_t)nxt.pn * tstep : cB;
        for (int t = 0; t < nt; t += 2) {
            const bool last = (t == nt - 2);
            const char* a1 = cA + (size_t)(t + 1) * kstep;
            const char* a2 = last ? nA : cA + (size_t)(t + 2) * kstep; const char* b2 = last ? nB : cB + (size_t)(t + 2) * kstep;
            const char* a3 = a2 + kstep; const char* b3 = b2 + kstep;
            if (last && has_next) S.a_ready(nxt);
            if constexpr (SP2) {
            PG8_LDB(B0, 0, 0); PG8_LDB(B1, 0, 1); PG8_SCHED; PG8_LDA(At, 0, 0); PG8_STAGE(PG8_SA(1, 1), a1 + hstep, voffA);
            PG8_WAIT_V(8); PG8_WAIT_L(0); PG8_BAR; PG8_MMA(0, 0, At, B0); PG8_MMA(0, 1, At, B1); PG8_BAR; PG8_SCHED;
            PG8_LDA(At, 0, 1); PG8_STAGE(PG8_SB(0, 0), b2, voffB); PG8_STAGE(PG8_SB(0, 1), b2 + hstep, voffB); PG8_STAGE(PG8_SA(0, 0), a2, voffA);
            PG8_WAIT_V(8); PG8_WAIT_L(0); PG8_BAR; PG8_MMA(1, 0, At, B0); PG8_MMA(1, 1, At, B1); PG8_BAR; PG8_SCHED;
            PG8_LDB(B0, 1, 0); PG8_LDB(B1, 1, 1); PG8_SCHED; PG8_LDA(At, 1, 0); PG8_STAGE(PG8_SA(0, 1), a2 + hstep, voffA);
            PG8_WAIT_V(8); PG8_WAIT_L(0); PG8_BAR; PG8_MMA(0, 0, At, B0); PG8_MMA(0, 1, At, B1); PG8_BAR; PG8_SCHED;
            PG8_LDA(At, 1, 1); PG8_STAGE(PG8_SB(1, 0), b3, voffB); PG8_STAGE(PG8_SB(1, 1), b3 + hstep, voffB); PG8_STAGE(PG8_SA(1, 0), a3, voffA);
            PG8_WAIT_V(8); PG8_WAIT_L(0); PG8_BAR; PG8_MMA(1, 0, At, B0); PG8_MMA(1, 1, At, B1); PG8_BAR; PG8_SCHED;
            } else {
            PG8_LDB(B0, 0, 0); PG8_SCHED; PG8_LDA(At, 0, 0); PG8_STAGE(PG8_SA(1, 1), a1 + hstep, voffA);
            PG8_WAIT_L(8); PG8_BAR; PG8_WAIT_L(0); PG8_MMA(0, 0, At, B0); PG8_BAR; PG8_SCHED;
            PG8_LDB(B1, 0, 1); PG8_STAGE(PG8_SB(0, 0), b2, voffB);
            PG8_BAR; PG8_WAIT_L(0); PG8_MMA(0, 1, At, B1); PG8_BAR;
            PG8_LDA(At, 0, 1); PG8_STAGE(PG8_SA(0, 0), a2, voffA);
            PG8_BAR; PG8_WAIT_L(0); PG8_MMA(1, 0, At, B0); PG8_BAR; PG8_SCHED;
            PG8_STAGE(PG8_SB(0, 1), b2 + hstep, voffB);
            PG8_WAIT_V(6); PG8_BAR; PG8_MMA(1, 1, At, B1); PG8_BAR;
            PG8_LDB(B0, 1, 0); PG8_SCHED; PG8_LDA(At, 1, 0); PG8_STAGE(PG8_SA(0, 1), a2 + hstep, voffA);
            PG8_WAIT_L(8); PG8_BAR; PG8_WAIT_L(0); PG8_MMA(0, 0, At, B0); PG8_BAR; PG8_SCHED;
            PG8_LDB(B1, 1, 1); PG8_STAGE(PG8_SB(1, 0), b3, voffB);
            PG8_BAR; PG8_WAIT_L(0); PG8_MMA(0, 1, At, B1); PG8_BAR;
            PG8_LDA(At, 1, 1); PG8_STAGE(PG8_SA(1, 0), a3, voffA);
            PG8_BAR; PG8_WAIT_L(0); PG8_MMA(1, 0, At, B0); PG8_BAR; PG8_SCHED;
            PG8_STAGE(PG8_SB(1, 1), b3 + hstep, voffB);
            PG8_WAIT_V(6); PG8_BAR; PG8_MMA(1, 1, At, B1); PG8_BAR;
            }
        }
        if constexpr (ALIGN_EPI) { if (wr == 0) PG8_BAR; }
        if constexpr (!Epi::AFTER_DRAIN) { E(acc, cur, wr, wc, fr, fq); S.done(cur); }
        if (!has_next) break;
#pragma unroll
        for (int a = 0; a < 2; ++a)
#pragma unroll
            for (int b = 0; b < 2; ++b)
#pragma unroll
                for (int m = 0; m < 4; ++m)
#pragma unroll
                    for (int n = 0; n < 2; ++n) acc[a][b][m][n] = (f32x4){0.f, 0.f, 0.f, 0.f};
        cur = nxt; cA = nA; cB = nB; ++ui;
        if constexpr (ALIGN_EPI) { if (wr == 1) PG8_BAR; }
    }
    PG8_WAIT_V(0);
    if constexpr (!ALIGN_EPI) { if (wr == 0) PG8_BAR; }
    PG8_BAR;
    if constexpr (Epi::AFTER_DRAIN) { E.fused(acc, cur, wr, wc, fr, fq, lds, wid, lane); S.done(cur); }
#undef PG8_SA
#undef PG8_SB
#undef PG8_STAGE
#undef PG8_LDA
#undef PG8_LDB
#undef PG8_MMA
#undef PG8_WAIT_V
#undef PG8_WAIT_L
#undef PG8_BAR
#undef PG8_SCHED
}
}
#define DI __device__ __forceinline__
#define LAS __attribute__((address_space(3)))
typedef unsigned short bf16;
typedef short bf16x8 __attribute__((ext_vector_type(8)));
typedef float f32x16 __attribute__((ext_vector_type(16)));
typedef float f32x4 __attribute__((ext_vector_type(4)));
typedef float f32x2 __attribute__((ext_vector_type(2)));
typedef unsigned u32x4 __attribute__((ext_vector_type(4)));
typedef unsigned u32x2 __attribute__((ext_vector_type(2)));
constexpr int NB = 4, S = 8192, T = NB * S, D = 1024, FF = 4096, HW = 2048  ;
constexpr int C_QLAT = 0, C_KVLAT = 256, C_KROPE = 512, C_NQ = 544, C_KC = 1056, C_VC = 1184, C_KS = 1312, C_VS = 1440, C_KW = 1568, C_VW = 1696, C_GATE = 1824, L0W = 1848;
constexpr float LN_EPS = 1e-5f, RMS_EPS = 1e-6f, ALPHA = 1.4142135623730951f, LOG2E = 1.4426950408889634f, NEGF = -1e30f;
constexpr float LAM_INIT = 0.35550906759096934f;
constexpr size_t MiB = 1u << 20;
constexpr size_t WS_WIN = 0, WS_WUQ = 4 * MiB, WS_WUKV = WS_WUQ + 768 * 256 * 2, WS_W1 = 5 * MiB, WS_WOUT = 6 * MiB, WS_WUP0 = 8 * MiB, WS_WDN0 = 16 * MiB, WS_WQKV = 24 * MiB, WS_WO = 30 * MiB, WS_WUP1 = 32 * MiB, WS_WDN1 = 40 * MiB;
constexpr size_t WS_STATS = 48 * MiB;
constexpr size_t WS_H = 50 * MiB;
constexpr size_t WS_XB = 178 * MiB;
constexpr size_t WS_QLN = 242 * MiB, WS_KVLN = 258 * MiB;
constexpr size_t WS_ACMP = 274 * MiB;
constexpr size_t WS_QRAW = 306 * MiB;
constexpr size_t WS_KV = 354 * MiB;
constexpr size_t WS_VTS = 418 * MiB, WS_VTW = 426 * MiB;
constexpr size_t WS_HID = 242 * MiB;
constexpr size_t WS_QKV = 242 * MiB;
constexpr size_t WS_VTD = 434 * MiB;
constexpr size_t WS_END = 498 * MiB;
constexpr size_t DO_OC = 0, DO_CH = 64 * MiB, DO_ROPE = 72 * MiB, DO_GATE = 73 * MiB, DO_KPE = 76 * MiB, DO_KC = 78 * MiB, DO_VCT = DO_KC + 512 * 1024, DO_SELM = 79 * MiB;
constexpr int LDS_BYTES = 147456;
constexpr size_t WS_CTL = 500 * MiB; constexpr int KN_WORD = 3584;

DI unsigned f2bf(float f) { unsigned u = __builtin_bit_cast(unsigned, f); return (u + 0x7fffu + ((u >> 16) & 1u)) >> 16; }
DI float bf2f(unsigned short h) { return __builtin_bit_cast(float, (unsigned)h << 16); }
DI unsigned pk2(float lo, float hi) { typedef __bf16 b2 __attribute__((ext_vector_type(2))); f32x2 v = {lo, hi}; b2 r = __builtin_convertvector(v, b2); return __builtin_bit_cast(unsigned, r); }
DI float wave_sum(float v) {
#pragma unroll
    for (int o = 1; o < 64; o <<= 1) v += __shfl_xor(v, o);
    return v; }
DI float xh_max(float v) { auto rr = __builtin_amdgcn_permlane32_swap(__float_as_uint(v), __float_as_uint(v), false, false); return fmaxf(__uint_as_float(rr[0]), __uint_as_float(rr[1])); }
DI float xh_sum(float v) { auto rr = __builtin_amdgcn_permlane32_swap(__float_as_uint(v), __float_as_uint(v), false, false); return __uint_as_float(rr[0]) + __uint_as_float(rr[1]); }

#define MFMA32(a, b, c) __builtin_amdgcn_mfma_f32_32x32x16_bf16((a), (b), (c), 0, 0, 0)
enum { M_CAUSAL = 0, M_WINDOW = 1, M_SEL = 2, M_CMP = 3 };
constexpr int STG = 28672;
DI int pi_row(int i) { const int j = i >> 4, w = i & 15; return 16 * j + 8 * ((w >> 2) & 1) + 4 * (w >> 3) + (w & 3); }
struct KVSrc { const bf16* K; int kp; const bf16* K2; const bf16* Vt; int vp; };
struct StageRegs { u32x4 k0, k1, v0, v1; };
template <int DQK, int DV> DI void stage_load(StageRegs& r, const KVSrc& s, int kb, int tid) {
    r.k0 = *(const u32x4*)(s.K + (size_t)(kb + (tid >> 3)) * s.kp + (tid & 7) * 8);
    if (DQK == 96) { if (tid < 256) r.k1 = *(const u32x4*)(s.K2 + (size_t)(kb + (tid >> 2)) * 32 + (tid & 3) * 8); }
    r.v0 = *(const u32x4*)(s.Vt + (size_t)(tid >> 3) * s.vp + kb + (tid & 7) * 8);
    if (DV == 128) r.v1 = *(const u32x4*)(s.Vt + (size_t)(64 + (tid >> 3)) * s.vp + kb + (tid & 7) * 8);
}
template <int DQK, int DV> DI void stage_store(const StageRegs& r, LAS char* buf, int tid) {
    constexpr int KSB = (DQK + 8) * 2, VOFF = 64 * KSB;
    *(LAS u32x4*)(buf + (tid >> 3) * KSB + (tid & 7) * 16) = r.k0;
    if (DQK == 96) { if (tid < 256) *(LAS u32x4*)(buf + (tid >> 2) * KSB + 128 + (tid & 3) * 16) = r.k1; }
    *(LAS u32x4*)(buf + VOFF + (tid >> 3) * 144 + (tid & 7) * 16) = r.v0;
    if (DV == 128) *(LAS u32x4*)(buf + VOFF + (64 + (tid >> 3)) * 144 + (tid & 7) * 16) = r.v1;
}
template <int DQK> DI void qk_tile(f32x16& s0, f32x16& s1, const LAS char* kbuf, const bf16x8 (&qf)[DQK / 16], int koff) {
    constexpr int KSB = (DQK + 8) * 2;
    bf16x8 a0[DQK / 16], a1[DQK / 16];
#pragma unroll
    for (int d0 = 0; d0 < DQK / 16; ++d0) { a0[d0] = *(const LAS bf16x8*)(kbuf + koff + d0 * 32); a1[d0] = *(const LAS bf16x8*)(kbuf + koff + 32 * KSB + d0 * 32); }
    __builtin_amdgcn_sched_barrier(0);
    f32x16 z;
#pragma unroll
    for (int r = 0; r < 16; ++r) z[r] = 0.f;
    s0 = MFMA32(a0[0], qf[0], z); s1 = MFMA32(a1[0], qf[0], z);
#pragma unroll
    for (int d0 = 1; d0 < DQK / 16; ++d0) { s0 = MFMA32(a0[d0], qf[d0], s0); s1 = MFMA32(a1[d0], qf[d0], s1); }
}
DI void v_load4(bf16x8 (&v)[4], const LAS char* vbuf, int voff, int blk) {
#pragma unroll
    for (int j = 0; j < 4; ++j) v[j] = *(const LAS bf16x8*)(vbuf + voff + blk * 32 * 144 + j * 32);
}
template <int MODE, bool ALIBI> DI void score_fix(f32x16& s0, f32x16& s1, float c2, float slope2, int dql, bool need_mask, bool lane_ok) {
    constexpr int KM = (MODE == M_CMP) ? 16 : 1;
    const float bl = ALIBI ? -slope2 * (float)dql : 0.f;
#pragma unroll
    for (int kh = 0; kh < 2; ++kh)
#pragma unroll
        for (int r = 0; r < 16; ++r) { const int kc = KM * (32 * kh + 16 * (r >> 3) + (r & 7));
            float v = kh ? s1[r] : s0[r];
            v = ALIBI ? __builtin_fmaf(v, c2, bl + slope2 * (float)kc) : v * c2;
            if (kh) s1[r] = v; else s0[r] = v; }
    if (need_mask) {
#pragma unroll
        for (int kh = 0; kh < 2; ++kh)
#pragma unroll
            for (int r = 0; r < 16; ++r) { const int kc = KM * (32 * kh + 16 * (r >> 3) + (r & 7));
                bool ok = kc <= dql; if (MODE == M_WINDOW) ok = ok && (kc > dql - 512);
                if (kh) s1[r] = ok ? s1[r] : NEGF; else s0[r] = ok ? s0[r] : NEGF; }
    }
    if (MODE == M_SEL) { if (!lane_ok) {
#pragma unroll
        for (int r = 0; r < 16; ++r) { s0[r] = NEGF; s1[r] = NEGF; } } }
}
DI float mx3(float a, float b, float c) { return __builtin_fmaxf(__builtin_fmaxf(a, b), c); }
DI float tile_max(const f32x16& s0, const f32x16& s1) {
    float a = mx3(s0[0], s0[1], s1[0]), b = mx3(s0[2], s0[3], s1[1]); a = mx3(a, s1[2], s1[3]);
#pragma unroll
    for (int r = 4; r < 16; r += 4) { a = mx3(a, s0[r], s0[r + 1]); b = mx3(b, s0[r + 2], s0[r + 3]); a = mx3(a, s1[r], s1[r + 1]); b = mx3(b, s1[r + 2], s1[r + 3]); }
    return xh_max(fmaxf(a, b)); }
DI void pack_p(bf16x8 (&pf)[4], const f32x16& s0, const f32x16& s1) {
#pragma unroll
    for (int j = 0; j < 2; ++j) { u32x4 w0, w1;
        w0.x = pk2(s0[8 * j], s0[8 * j + 1]); w0.y = pk2(s0[8 * j + 2], s0[8 * j + 3]); w0.z = pk2(s0[8 * j + 4], s0[8 * j + 5]); w0.w = pk2(s0[8 * j + 6], s0[8 * j + 7]);
        w1.x = pk2(s1[8 * j], s1[8 * j + 1]); w1.y = pk2(s1[8 * j + 2], s1[8 * j + 3]); w1.z = pk2(s1[8 * j + 4], s1[8 * j + 5]); w1.w = pk2(s1[8 * j + 6], s1[8 * j + 7]);
        pf[j] = __builtin_bit_cast(bf16x8, w0); pf[2 + j] = __builtin_bit_cast(bf16x8, w1); }
}
template <int DV> DI void pv_tile(f32x16 (&o)[DV / 32], const LAS char* vbuf, const bf16x8 (&pf)[4], int voff, const bf16x8 (&v0)[4]) {
    if (DV == 64) {
        bf16x8 vn[4]; v_load4(vn, vbuf, voff, 1);
        __builtin_amdgcn_sched_barrier(0);
#pragma unroll
        for (int j = 0; j < 4; ++j) o[0] = MFMA32(v0[j], pf[j], o[0]);
#pragma unroll
        for (int j = 0; j < 4; ++j) o[1] = MFMA32(vn[j], pf[j], o[1]);
    } else {
#pragma unroll
        for (int blk = 0; blk < DV / 32; ++blk) {
            bf16x8 vc[4]; v_load4(vc, vbuf, voff, blk);
            __builtin_amdgcn_sched_barrier(0);
#pragma unroll
            for (int j = 0; j < 4; ++j) o[blk] = MFMA32(vc[j], pf[j], o[blk]);
        }
    }
}
template <int MODE> DI int next_tile(int t, int t0, unsigned u0, unsigned u1, unsigned u2, unsigned u3) {
    --t;
    if (MODE == M_SEL) { while (t >= t0) { const unsigned w = (t < 32) ? u0 : (t < 64) ? u1 : (t < 96) ? u2 : u3; if ((w >> (t & 31)) & 1u) break; --t; } }
    return t >= t0 ? t : -1;
}
template <int DQK, bool ALIBI> DI void qk_tile2(f32x16& s0, f32x16& s1, const LAS char* kbuf, const bf16x8 (&qf)[DQK / 16], int koff, bf16x8 qx, bf16x8 kx0) {
    constexpr int KSB = (DQK + 8) * 2, NH = DQK / 32;
    bf16x8 a0[NH], a1[NH];
#pragma unroll
    for (int d0 = 0; d0 < NH; ++d0) { a0[d0] = *(const LAS bf16x8*)(kbuf + koff + d0 * 32); a1[d0] = *(const LAS bf16x8*)(kbuf + koff + 32 * KSB + d0 * 32); }
    __builtin_amdgcn_sched_barrier(0);
    f32x16 z;
#pragma unroll
    for (int r = 0; r < 16; ++r) z[r] = 0.f;
    if (ALIBI) { s0 = MFMA32(kx0, qx, z); s1 = MFMA32(kx0, qx, z); s0 = MFMA32(a0[0], qf[0], s0); s1 = MFMA32(a1[0], qf[0], s1); }
    else { s0 = MFMA32(a0[0], qf[0], z); s1 = MFMA32(a1[0], qf[0], z); }
    bf16x8 b0[DQK / 16 - NH], b1[DQK / 16 - NH];
#pragma unroll
    for (int d0 = NH; d0 < DQK / 16; ++d0) { b0[d0 - NH] = *(const LAS bf16x8*)(kbuf + koff + d0 * 32); b1[d0 - NH] = *(const LAS bf16x8*)(kbuf + koff + 32 * KSB + d0 * 32); }
    __builtin_amdgcn_sched_barrier(0);
#pragma unroll
    for (int d0 = 1; d0 < NH; ++d0) { s0 = MFMA32(a0[d0], qf[d0], s0); s1 = MFMA32(a1[d0], qf[d0], s1); }
#pragma unroll
    for (int d0 = NH; d0 < DQK / 16; ++d0) { s0 = MFMA32(b0[d0 - NH], qf[d0], s0); s1 = MFMA32(b1[d0 - NH], qf[d0], s1); }
}
template <int DQK, int DV, int MODE, bool ALIBI>
DI bool tile_compute(f32x16 (&o)[DV / 32], float& m, float& l, const bf16x8 (&qf)[DQK / 16], bf16x8 qx, bf16x8 kx0, const LAS char* buf, int t, int qpos, int q0w, u32x4 sel,
                     float c2, float slope2, float qbound, int koff, int voff) {
    const int kbase = 64 * t;
    bool lane_ok = true; if (MODE == M_SEL) { const unsigned w = (t < 32) ? sel.x : (t < 64) ? sel.y : (t < 96) ? sel.z : sel.w; lane_ok = (w >> (t & 31)) & 1u; }
    bool skip = (kbase > q0w + 31); if (MODE == M_WINDOW) skip = skip || (kbase + 63 < q0w - 511);
    if (MODE == M_SEL) skip = skip || !__any(lane_ok);
    bool dead = false;
    if (ALIBI) { const int dmin = qpos - kbase - 63; const float ub = qbound - slope2 * (float)(dmin > 0 ? dmin : 0); dead = __all(ub < m - 40.f); skip = skip || dead; }
    if (!skip) {
        f32x16 s0, s1; qk_tile2<DQK, ALIBI>(s0, s1, buf, qf, koff, qx, kx0);
        bf16x8 v0[4]; if (DV == 64) { v_load4(v0, buf, voff, 0); __builtin_amdgcn_sched_barrier(0); }
        bool need_mask = kbase + 63 > q0w; if (MODE == M_WINDOW) need_mask = need_mask || (q0w + 31 - kbase >= 512);
        const int dq = qpos - kbase;
        const float tb = (ALIBI ? -slope2 * (float)dq : 0.f) - m, tb1 = ALIBI ? tb + 32.f * slope2 : tb;
#pragma unroll
        for (int r = 0; r < 16; ++r) { s0[r] = __builtin_fmaf(s0[r], c2, tb); s1[r] = __builtin_fmaf(s1[r], c2, tb1); }
        if (need_mask || MODE == M_SEL) {
            const int dqh = lane_ok ? dq - 8 * (int)((threadIdx.x >> 5) & 1) : -1000000;
#pragma unroll
            for (int kh = 0; kh < 2; ++kh)
#pragma unroll
                for (int r = 0; r < 16; ++r) { const int kc = 32 * kh + 16 * (r >> 3) + (r & 7);
                    bool ok = (kc <= dqh); if (MODE == M_WINDOW) ok = ok && (kc > dqh - 512);
                    if (kh) s1[r] = ok ? s1[r] : NEGF; else s0[r] = ok ? s0[r] : NEGF; }
        }
        const float mx = tile_max(s0, s1);
        if (__any(mx > 6.f)) { const float dl = fmaxf(mx, 0.f), f = __builtin_amdgcn_exp2f(-dl); m += dl; l *= f;
#pragma unroll
            for (int r = 0; r < 16; ++r) { s0[r] -= dl; s1[r] -= dl; }
#pragma unroll
            for (int blk = 0; blk < DV / 32; ++blk) o[blk] *= f; }
        float sum = 0.f;
#pragma unroll
        for (int r = 0; r < 16; ++r) { s0[r] = __builtin_amdgcn_exp2f(s0[r]); s1[r] = __builtin_amdgcn_exp2f(s1[r]); sum += s0[r] + s1[r]; }
        l += sum;
        bf16x8 pf[4]; pack_p(pf, s0, s1);
        pv_tile<DV>(o, buf, pf, voff, v0);
    }
    return dead;
}
template <int DQK, int DV, int MODE, bool ALIBI>
DI void run_tiles(f32x16 (&o)[DV / 32], float& m, float& l, const bf16x8 (&qf)[DQK / 16], const KVSrc& src, int t0, int t1, unsigned u0, unsigned u1, unsigned u2, unsigned u3,
                  int qpos, int q0w, u32x4 sel, float c2, float slope2, float knmax, LAS char* lds, int tid, int lane) {
    constexpr int KSB = (DQK + 8) * 2, VOFF = 64 * KSB;
    const int l31 = lane & 31, hi = lane >> 5;
    const int koff = pi_row(l31) * KSB + hi * 16, voff = VOFF + l31 * 144 + hi * 16;
    bf16x8 qx, kx0; float qbound = 0.f;
#pragma unroll
    for (int e = 0; e < 8; ++e) { qx[e] = 0; kx0[e] = 0; }
    if (ALIBI) {
        const float sq = slope2 / c2; const unsigned sh = f2bf(sq); const float rem = sq - __builtin_bit_cast(float, sh << 16); const unsigned slo = f2bf(rem);
        if (hi == 0) { qx[0] = (short)sh; qx[1] = (short)slo; const short a = (short)f2bf((float)pi_row(l31)); kx0[0] = a; kx0[1] = a; }
        float ss = 0.f;
#pragma unroll
        for (int d0 = 0; d0 < DQK / 16; ++d0)
#pragma unroll
            for (int e = 0; e < 8; ++e) { const float x = bf2f((unsigned short)qf[d0][e]); ss += x * x; }
        qbound = sqrtf(xh_sum(ss)) * knmax * c2 * 1.001f + 0.01f;
    }
    { const bf16* kd = src.K + (size_t)qpos * src.kp + 8 * hi; float dot = 0.f;
#pragma unroll
      for (int d0 = 0; d0 < DQK / 16; ++d0) { const bf16x8 kk = (DQK == 96 && d0 >= 4) ? *(const bf16x8*)(src.K2 + (size_t)qpos * 32 + (d0 - 4) * 16 + 8 * hi) : *(const bf16x8*)(kd + d0 * 16);
#pragma unroll
          for (int e = 0; e < 8; ++e) dot += bf2f((unsigned short)kk[e]) * bf2f((unsigned short)qf[d0][e]); }
      m = xh_sum(dot) * c2; }
    StageRegs sr; int t = t1, cur = 0;
    LAS int* dslot = (LAS int*)(lds + 2 * STG + 256);
    const int wid_ = tid >> 6; bool counted = false;
    if (ALIBI) { if (lane == 0) dslot[wid_] = -1; }
    stage_load<DQK, DV>(sr, src, 64 * t, tid); stage_store<DQK, DV>(sr, lds, tid); __syncthreads();
    while (t >= 0) {
        const int tn = next_tile<MODE>(t, t0, u0, u1, u2, u3);
        if (tn >= 0) stage_load<DQK, DV>(sr, src, 64 * tn, tid);
        const bool dead = tile_compute<DQK, DV, MODE, ALIBI>(o, m, l, qf, qx, kx0, lds + cur * STG, t, qpos, q0w, sel, c2, slope2, qbound, koff, voff);
        if (ALIBI) { if (dead && !counted) { if (lane == 0) dslot[wid_] = t; counted = true; } }
        if (tn >= 0) stage_store<DQK, DV>(sr, lds + (cur ^ 1) * STG, tid);
        __syncthreads();
        if (ALIBI) { const u32x4 d0 = *(const LAS u32x4*)dslot, d1 = *(const LAS u32x4*)(dslot + 4);
            const bool all = (int)d0.x >= t && (int)d0.y >= t && (int)d0.z >= t && (int)d0.w >= t && (int)d1.x >= t && (int)d1.y >= t && (int)d1.z >= t && (int)d1.w >= t;
            if (__builtin_amdgcn_readfirstlane((int)all)) break; }
        cur ^= 1; t = tn;
    }
    __syncthreads();
}
template <int DQK, int DV>
DI void run_tiles2(f32x16 (&o)[DV / 32], float& m, float& l, const bf16x8 (&qf)[DQK / 16], const KVSrc& src, int t1, int qpos, int q0w, float c2, LAS char* lds, int tid, int lane) {
    constexpr int KSB = (DQK + 8) * 2, VOFF = 64 * KSB;
    const int l31 = lane & 31, hi = lane >> 5;
    const int koff = pi_row(l31) * KSB + hi * 16, voff = VOFF + l31 * 144 + hi * 16;
    { const bf16* kd = src.K + (size_t)qpos * src.kp + 8 * hi; float dot = 0.f;
#pragma unroll
      for (int d0 = 0; d0 < DQK / 16; ++d0) { const bf16x8 kk = (DQK == 96 && d0 >= 4) ? *(const bf16x8*)(src.K2 + (size_t)qpos * 32 + (d0 - 4) * 16 + 8 * hi) : *(const bf16x8*)(kd + d0 * 16);
#pragma unroll
          for (int e = 0; e < 8; ++e) dot += bf2f((unsigned short)kk[e]) * bf2f((unsigned short)qf[d0][e]); }
      m = xh_sum(dot) * c2; }
    bf16x8 qx;
#pragma unroll
    for (int e = 0; e < 8; ++e) qx[e] = 0;
    StageRegs ra, rb; int ta = t1, cur = 0;
    stage_load<DQK, DV>(ra, src, 64 * ta, tid); stage_load<DQK, DV>(rb, src, 64 * (ta - 1), tid);
    stage_store<DQK, DV>(ra, lds, tid); stage_store<DQK, DV>(rb, lds + STG, tid); __syncthreads();
    while (ta >= 0) {
        const int tn = ta - 2;
        if (tn >= 0) { stage_load<DQK, DV>(ra, src, 64 * tn, tid); stage_load<DQK, DV>(rb, src, 64 * (tn - 1), tid); }
        const LAS char* bufa = lds + (2 * cur) * STG; const LAS char* bufb = bufa + STG;
        const int kba = 64 * ta, kbb = kba - 64;
        if (!(kbb > q0w + 31)) {
            f32x16 a0, a1, b0, b1;
            { f32x16 z;
#pragma unroll
              for (int r = 0; r < 16; ++r) z[r] = 0.f;
              a0 = z; a1 = z; b0 = z; b1 = z;
              bf16x8 fa0 = *(const LAS bf16x8*)(bufa + koff), fa1 = *(const LAS bf16x8*)(bufa + koff + 32 * KSB), fb0 = *(const LAS bf16x8*)(bufb + koff), fb1 = *(const LAS bf16x8*)(bufb + koff + 32 * KSB);
#pragma unroll
              for (int d0 = 0; d0 < DQK / 16; ++d0) {
                  bf16x8 na0 = fa0, na1 = fa1, nb0 = fb0, nb1 = fb1;
                  if (d0 + 1 < DQK / 16) { na0 = *(const LAS bf16x8*)(bufa + koff + (d0 + 1) * 32); na1 = *(const LAS bf16x8*)(bufa + koff + 32 * KSB + (d0 + 1) * 32); nb0 = *(const LAS bf16x8*)(bufb + koff + (d0 + 1) * 32); nb1 = *(const LAS bf16x8*)(bufb + koff + 32 * KSB + (d0 + 1) * 32); }
                  __builtin_amdgcn_sched_barrier(0);
                  a0 = MFMA32(fa0, qf[d0], a0); a1 = MFMA32(fa1, qf[d0], a1); b0 = MFMA32(fb0, qf[d0], b0); b1 = MFMA32(fb1, qf[d0], b1);
                  fa0 = na0; fa1 = na1; fb0 = nb0; fb1 = nb1; } }
            const float tb = -m;
#pragma unroll
            for (int r = 0; r < 16; ++r) { a0[r] = __builtin_fmaf(a0[r], c2, tb); a1[r] = __builtin_fmaf(a1[r], c2, tb); b0[r] = __builtin_fmaf(b0[r], c2, tb); b1[r] = __builtin_fmaf(b1[r], c2, tb); }
            if (kba + 63 > q0w) { const int dqa = qpos - kba - 8 * hi, dqb = dqa + 64;
#pragma unroll
                for (int kh = 0; kh < 2; ++kh)
#pragma unroll
                    for (int r = 0; r < 16; ++r) { const int kc = 32 * kh + 16 * (r >> 3) + (r & 7); const bool oka = (kc <= dqa), okb = (kc <= dqb);
                        if (kh) { a1[r] = oka ? a1[r] : NEGF; b1[r] = okb ? b1[r] : NEGF; } else { a0[r] = oka ? a0[r] : NEGF; b0[r] = okb ? b0[r] : NEGF; } } }
            const float mx = fmaxf(tile_max(a0, a1), tile_max(b0, b1));
            if (__any(mx > 6.f)) { const float dl = fmaxf(mx, 0.f), f = __builtin_amdgcn_exp2f(-dl); m += dl; l *= f;
#pragma unroll
                for (int r = 0; r < 16; ++r) { a0[r] -= dl; a1[r] -= dl; b0[r] -= dl; b1[r] -= dl; }
#pragma unroll
                for (int blk = 0; blk < DV / 32; ++blk) o[blk] *= f; }
            float sum = 0.f;
#pragma unroll
            for (int r = 0; r < 16; ++r) { a0[r] = __builtin_amdgcn_exp2f(a0[r]); a1[r] = __builtin_amdgcn_exp2f(a1[r]); b0[r] = __builtin_amdgcn_exp2f(b0[r]); b1[r] = __builtin_amdgcn_exp2f(b1[r]); sum += (a0[r] + a1[r]) + (b0[r] + b1[r]); }
            l += sum;
            bf16x8 pa[4], pb[4]; pack_p(pa, a0, a1); pack_p(pb, b0, b1);
#pragma unroll
            for (int blk = 0; blk < DV / 32; ++blk) {
                { bf16x8 vc[4]; v_load4(vc, bufa, voff, blk); __builtin_amdgcn_sched_barrier(0);
#pragma unroll
                  for (int j = 0; j < 4; ++j) o[blk] = MFMA32(vc[j], pa[j], o[blk]); }
                { bf16x8 vc[4]; v_load4(vc, bufb, voff, blk); __builtin_amdgcn_sched_barrier(0);
#pragma unroll
                  for (int j = 0; j < 4; ++j) o[blk] = MFMA32(vc[j], pb[j], o[blk]); }
            }
        }
        if (tn >= 0) { stage_store<DQK, DV>(ra, lds + (2 * (cur ^ 1)) * STG, tid); stage_store<DQK, DV>(rb, lds + (2 * (cur ^ 1) + 1) * STG, tid); }
        __syncthreads();
        cur ^= 1; ta = tn;
    }
}
template <int DQK> DI void load_q(bf16x8 (&qf)[DQK / 16], const bf16* Qrow, int hi) {
#pragma unroll
    for (int d0 = 0; d0 < DQK / 16; ++d0) qf[d0] = *(const bf16x8*)(Qrow + d0 * 16 + hi * 8);
}
template <int DV> DI void store_o_bf16(const f32x16 (&o)[DV / 32], float inv, bf16* dst, int hi) {
#pragma unroll
    for (int blk = 0; blk < DV / 32; ++blk)
#pragma unroll
        for (int rr = 0; rr < 4; ++rr) { u32x2 w; w.x = pk2(o[blk][4 * rr] * inv, o[blk][4 * rr + 1] * inv); w.y = pk2(o[blk][4 * rr + 2] * inv, o[blk][4 * rr + 3] * inv);
            *(u32x2*)(dst + 32 * blk + 8 * rr + 4 * hi) = w; }
}
#define RLX_AGENT __ATOMIC_RELAXED, __HIP_MEMORY_SCOPE_AGENT
#define XB_TMO      128
#define XB_XCNT(j)  (256  + 64 * (j))
#define XB_XSUB(j)  (1280 + 64 * (j))
#define XB_XGEN(j)  (2304 + 64 * (j))
#define XB_TOP      3328
#define XB_TOPGEN   3392
#define XCD_BAR_WORDS 3456
#define XB_SPIN_CAP (1u << 18)

__device__ __forceinline__ unsigned xb_ld(unsigned* p)              { return __hip_atomic_load(p, __ATOMIC_RELAXED, __HIP_MEMORY_SCOPE_AGENT); }
__device__ __forceinline__ unsigned xb_add(unsigned* p, unsigned v) { return __hip_atomic_fetch_add(p, v, __ATOMIC_RELAXED, __HIP_MEMORY_SCOPE_AGENT); }
__device__ __forceinline__ unsigned xb_xcc_id() { return (unsigned)__builtin_amdgcn_s_getreg((3 << 11) | 20) & 0xFu; }
#define XB_SPIN(cond, bar) do { unsigned _sp = 0; while (cond) { __builtin_amdgcn_s_sleep(1); \
    if ((++_sp & 255u) == 0u) { if (xb_ld(&(bar)[XB_TMO])) break; if (_sp > XB_SPIN_CAP) { atomicAdd(&(bar)[XB_TMO], 1u); break; } } } } while (0)

struct XcdBarrier {
    unsigned* bar; unsigned x;
    volatile LAS unsigned* st;
};

__device__ __forceinline__ XcdBarrier xcd_barrier_post(unsigned* bar, volatile LAS unsigned* st) {
    XcdBarrier b; b.bar = bar; b.x = xb_xcc_id(); b.st = st;
    if (threadIdx.x == 0) (void)xb_add(&bar[XB_XCNT(b.x)], 1u);
    return b;
}
__device__ __forceinline__ void xcd_barrier_complete(unsigned* bar, unsigned x, unsigned& nloc, unsigned& nx) {
    const unsigned G = gridDim.x * gridDim.y * gridDim.z;
    unsigned sum, cnt, mine, sp = 0u;
    for (;;) {
        sum = 0u; cnt = 0u; mine = 0u;
#pragma unroll
        for (unsigned j = 0; j < 16; ++j) { const unsigned c = xb_ld(&bar[XB_XCNT(j)]); sum += c; cnt += (c > 0u) ? 1u : 0u; mine = (j == x) ? c : mine; }
        if (sum == G) break;
        __builtin_amdgcn_s_sleep(1);
        if ((++sp & 255u) == 0u) { if (xb_ld(&bar[XB_TMO])) break; if (sp > XB_SPIN_CAP) { atomicAdd(&bar[XB_TMO], 1u); break; } }
    }
    nloc = mine > 0u ? mine : 1u; nx = cnt > 0u ? cnt : 1u;
}

__device__ __forceinline__ void xcd_barrier(const XcdBarrier& b) {
    asm volatile("s_waitcnt vmcnt(0)" ::: "memory");
    __syncthreads();
    if (threadIdx.x == 0) {
        unsigned* bar = b.bar;
        __builtin_amdgcn_s_waitcnt(0);
        unsigned nloc = b.st[0], nx = b.st[1];
        if (nloc == 0u) { xcd_barrier_complete(bar, b.x, nloc, nx); b.st[0] = nloc; b.st[1] = nx; }
        const unsigned old = xb_add(&bar[XB_XSUB(b.x)], 1u);
        const unsigned gen = old / nloc;
        if (old + 1u == (gen + 1u) * nloc) {
            __builtin_amdgcn_fence(__ATOMIC_RELEASE, "agent");
            asm volatile("s_waitcnt vmcnt(0)" ::: "memory");
            const unsigned og = xb_add(&bar[XB_TOP], 1u);
            const unsigned tg = og / nx;
            if (og + 1u == (tg + 1u) * nx) xb_add(&bar[XB_TOPGEN], 1u);
            else XB_SPIN(xb_ld(&bar[XB_TOPGEN]) == tg, bar);
            __builtin_amdgcn_fence(__ATOMIC_ACQUIRE, "agent");
            xb_add(&bar[XB_XGEN(b.x)], 1u);
            asm volatile("s_waitcnt vmcnt(0)" ::: "memory");
        } else {
            XB_SPIN(xb_ld(&bar[XB_XGEN(b.x)]) == gen, bar);
            __builtin_amdgcn_fence(__ATOMIC_ACQUIRE, "agent");
            asm volatile("s_waitcnt vmcnt(0)" ::: "memory");
        }
    }
    __syncthreads();
}
struct Ptrs {
    const float* in[32]; float* out; unsigned char* ws; unsigned char* dob;
};
DI int vcu_of(int bid, int G) { return (G % 8 == 0) ? (bid % 8) * (G / 8) + bid / 8 : bid; }

DI void mla_unit(const Ptrs& P, int b, int h, int qb, LAS char* lds, int tid, int lane, int wid) {
    asm volatile("" : "+v"(tid), "+v"(lane));
    const int l31 = lane & 31, hi = lane >> 5, q0 = qb * 256, q0w = q0 + 32 * wid, qpos = q0w + l31;
    const bf16* Qrow = (const bf16*)(P.ws + WS_QRAW) + (size_t)(b * S + qpos) * 768 + h * 96;
    bf16x8 qf[6]; load_q<96>(qf, Qrow, hi);
    { const f32x2* rp = (const f32x2*)(P.dob + DO_ROPE) + (size_t)qpos * 16 + 8 * hi; u32x4 a = __builtin_bit_cast(u32x4, qf[4]), c = __builtin_bit_cast(u32x4, qf[5]); unsigned ra[4], rc[4];
#pragma unroll
      for (int e = 0; e < 4; ++e) { const unsigned wa = a[e], wc = c[e]; const f32x2 cs0 = rp[2 * e], cs1 = rp[2 * e + 1];
          const float x1a = bf2f((unsigned short)(wa & 0xffffu)), x1b = bf2f((unsigned short)(wa >> 16)), x2a = bf2f((unsigned short)(wc & 0xffffu)), x2b = bf2f((unsigned short)(wc >> 16));
          ra[e] = pk2(x1a * cs0.x - x2a * cs0.y, x1b * cs1.x - x2b * cs1.y); rc[e] = pk2(x1a * cs0.y + x2a * cs0.x, x1b * cs1.y + x2b * cs1.x); }
      qf[4] = __builtin_bit_cast(bf16x8, (u32x4){ra[0], ra[1], ra[2], ra[3]}); qf[5] = __builtin_bit_cast(bf16x8, (u32x4){rc[0], rc[1], rc[2], rc[3]}); }
    KVSrc src; src.K = (const bf16*)(P.ws + WS_KV) + (size_t)(b * S) * 1024 + h * 128; src.kp = 1024; src.K2 = (const bf16*)(P.dob + DO_KPE) + (size_t)(b * S) * 32;
    src.Vt = (const bf16*)(P.ws + WS_QLN) + (size_t)((b * 8 + h) * 64) * S; src.vp = S;
    f32x16 o[2];
#pragma unroll
    for (int r = 0; r < 16; ++r) { o[0][r] = 0.f; o[1][r] = 0.f; }
    float m = NEGF, l = 0.f;
    run_tiles2<96, 64>(o, m, l, qf, src, (q0 + 255) >> 6, qpos, q0w, 0.10206207261596577f * LOG2E, lds, tid, lane);
    const float inv = 1.f / xh_sum(l);
    store_o_bf16<64>(o, inv, (bf16*)(P.ws + WS_XB) + (size_t)(b * S + qpos) * 1024 + h * 64, hi);
}
DI void diff_unit(const Ptrs& P, int b, int h, int j, int qb, LAS char* lds, int tid, int lane, int wid) {
    asm volatile("" : "+v"(tid), "+v"(lane));
    const int l31 = lane & 31, hi = lane >> 5, q0 = qb * 256, q0w = q0 + 32 * wid, qpos = q0w + l31;
    const bf16* QKV = (const bf16*)(P.ws + WS_QKV);
    bf16x8 qf[4]; load_q<64>(qf, QKV + (size_t)(b * S + qpos) * 3072 + h * 128 + j * 64, hi);
    KVSrc src; src.K = QKV + (size_t)(b * S) * 3072 + 1024 + h * 128 + j * 64; src.kp = 3072; src.K2 = nullptr;
    src.Vt = (const bf16*)(P.ws + WS_VTD) + (size_t)((b * 8 + h) * 128) * S; src.vp = S;
    f32x16 o[4];
#pragma unroll
    for (int r = 0; r < 16; ++r) { o[0][r] = 0.f; o[1][r] = 0.f; o[2][r] = 0.f; o[3][r] = 0.f; }
    float m = NEGF, l = 0.f;
    const float slope2 = __builtin_amdgcn_exp2f(-(float)(h + 1)) * LOG2E;
    const float knmax = sqrtf(__builtin_bit_cast(float, ((const unsigned*)(P.ws + WS_CTL))[KN_WORD + (b * 8 + h) * 2 + j]));
    run_tiles<64, 128, M_CAUSAL, true>(o, m, l, qf, src, 0, (q0 + 255) >> 6, 0u, 0u, 0u, 0u, qpos, q0w, (u32x4){0u, 0u, 0u, 0u}, 0.125f * LOG2E, slope2, knmax, lds, tid, lane);
    const float inv = 1.f / xh_sum(l);
    store_o_bf16<128>(o, inv, (bf16*)P.dob + (size_t)(b * S + qpos) * 2048 + h * 256 + j * 128, hi);
}
DI void nsa_sw_unit(const Ptrs& P, int b, int h, int qb, LAS char* lds, int tid, int lane, int wid) {
    asm volatile("" : "+v"(tid), "+v"(lane));
    const int l31 = lane & 31, hi = lane >> 5, q0 = qb * 256, q0w = q0 + 32 * wid, qpos = q0w + l31, g = h >> 2;
    const bf16* Hb = (const bf16*)(P.ws + WS_H);
    bf16x8 qf[4]; load_q<64>(qf, Hb + (size_t)(b * S + qpos) * HW + C_NQ + h * 64, hi);
    const float slope2 = __builtin_amdgcn_exp2f(-(float)(h + 1)) * LOG2E, c2 = 0.125f * LOG2E;
    f32x16 ow[2], os[2];
#pragma unroll
    for (int r = 0; r < 16; ++r) { ow[0][r] = 0.f; ow[1][r] = 0.f; os[0][r] = 0.f; os[1][r] = 0.f; }
    { KVSrc src; src.K = Hb + (size_t)(b * S) * HW + C_KW + g * 64; src.kp = HW; src.K2 = nullptr; src.Vt = (const bf16*)(P.ws + WS_VTW) + (size_t)((b * 2 + g) * 64) * S; src.vp = S;
      float m = NEGF, l = 0.f; int t0 = (q0 - 511) >> 6; if (t0 < 0) t0 = 0;
      run_tiles<64, 64, M_WINDOW, true>(ow, m, l, qf, src, t0, (q0 + 255) >> 6, 0u, 0u, 0u, 0u, qpos, q0w, (u32x4){0u, 0u, 0u, 0u}, c2, slope2, sqrtf(__builtin_bit_cast(float, ((const unsigned*)(P.ws + WS_CTL))[KN_WORD + 64 + 8 + b * 2 + g])), lds, tid, lane);
      const float inv = 1.f / xh_sum(l); ow[0] *= inv; ow[1] *= inv; }
    const u32x4 sel = *(const u32x4*)((const unsigned*)(P.dob + DO_SELM) + (size_t)((b * 2 + g) * S + qpos) * 4);
    unsigned u0 = sel.x, u1 = sel.y, u2 = sel.z, u3 = sel.w;
#pragma unroll
    for (int o = 1; o < 64; o <<= 1) { u0 |= __shfl_xor(u0, o); u1 |= __shfl_xor(u1, o); u2 |= __shfl_xor(u2, o); u3 |= __shfl_xor(u3, o); }
    LAS unsigned* ex = (LAS unsigned*)(lds + 2 * STG);
    if (lane == 0) { ex[wid * 4] = u0; ex[wid * 4 + 1] = u1; ex[wid * 4 + 2] = u2; ex[wid * 4 + 3] = u3; }
    __syncthreads();
    u0 = u1 = u2 = u3 = 0u;
#pragma unroll
    for (int w = 0; w < 8; ++w) { u0 |= ex[w * 4]; u1 |= ex[w * 4 + 1]; u2 |= ex[w * 4 + 2]; u3 |= ex[w * 4 + 3]; }
    u0 = __builtin_amdgcn_readfirstlane(u0) | 1u; u1 = __builtin_amdgcn_readfirstlane(u1); u2 = __builtin_amdgcn_readfirstlane(u2); u3 = __builtin_amdgcn_readfirstlane(u3);
    { KVSrc src; src.K = Hb + (size_t)(b * S) * HW + C_KS + g * 64; src.kp = HW; src.K2 = nullptr; src.Vt = (const bf16*)(P.ws + WS_VTS) + (size_t)((b * 2 + g) * 64) * S; src.vp = S;
      float m = NEGF, l = 0.f;
      run_tiles<64, 64, M_SEL, true>(os, m, l, qf, src, 0, (q0 + 255) >> 6, u0, u1, u2, u3, qpos, q0w, sel, c2, slope2, sqrtf(__builtin_bit_cast(float, ((const unsigned*)(P.ws + WS_CTL))[KN_WORD + 64 + b * 2 + g])), lds, tid, lane);
      const float inv = 1.f / xh_sum(l); os[0] *= inv; os[1] *= inv; }
    const size_t row = (size_t)(b * S + qpos);
    const float* gp = (const float*)(P.dob + DO_GATE) + row * 24 + h * 3; const float g0 = gp[0], g1 = gp[1], g2 = gp[2];
    const float* oc = (const float*)(P.dob + DO_OC) + row * 512 + h * 64; bf16* dst = (bf16*)(P.ws + WS_XB) + row * 1024 + 512 + h * 64;
#pragma unroll
    for (int blk = 0; blk < 2; ++blk)
#pragma unroll
        for (int rr = 0; rr < 4; ++rr) { const int d = 32 * blk + 8 * rr + 4 * hi; const f32x4 c = *(const f32x4*)(oc + d); float v[4];
#pragma unroll
            for (int e = 0; e < 4; ++e) v[e] = g0 * c[e] + g1 * os[blk][4 * rr + e] + g2 * ow[blk][4 * rr + e];
            u32x2 w; w.x = pk2(v[0], v[1]); w.y = pk2(v[2], v[3]); *(u32x2*)(dst + d) = w; }
}
constexpr int CSTG = 18432, C_PROW = 2 * CSTG, C_IMPH = C_PROW + 8 * 32 * 272;
DI void cmp_unit(const Ptrs& P, int b, int g, int qblk, LAS char* lds, int tid, int lane, int wid) {
    asm volatile("" : "+v"(tid), "+v"(lane));
    const int l31 = lane & 31, hi = lane >> 5, hh = wid & 3, qs = wid >> 2, h = 4 * g + hh, q0 = qblk * 64, q0w = q0 + 32 * qs, qpos = q0w + l31;
    const bf16* Hb = (const bf16*)(P.ws + WS_H);
    bf16x8 qf[4]; load_q<64>(qf, Hb + (size_t)(b * S + qpos) * HW + C_NQ + h * 64, hi);
    const float slope2 = __builtin_amdgcn_exp2f(-(float)(h + 1)) * LOG2E, c2 = 0.125f * LOG2E;
    KVSrc src; src.K = (const bf16*)(P.dob + DO_KC) + (size_t)((b * 2 + g) * 512) * 64; src.kp = 64; src.K2 = nullptr; src.Vt = (const bf16*)(P.dob + DO_VCT) + (size_t)((b * 2 + g) * 64) * 512; src.vp = 512;
    const int nt = (((q0 + 32) >> 4) >> 6) + 1;
    constexpr int KSB = 144, VOFF = 64 * KSB;
    const int koff = pi_row(l31) * KSB + hi * 16, voff = VOFF + l31 * 144 + hi * 16;
    float m = NEGF, l = 0.f; StageRegs sr;
    stage_load<64, 64>(sr, src, 0, tid); stage_store<64, 64>(sr, lds, tid); __syncthreads();
    for (int t = 0; t < nt; ++t) {
        if (t + 1 < nt) stage_load<64, 64>(sr, src, 64 * (t + 1), tid);
        const LAS char* buf = lds + (t & 1) * CSTG;
        f32x16 s0, s1; qk_tile<64>(s0, s1, buf, qf, koff);
        const int dql = qpos - 31 - 1024 * t - 128 * hi;
        score_fix<M_CMP, true>(s0, s1, c2, slope2, dql, 1024 * t + 1039 > q0w, true);
        const float mx = tile_max(s0, s1), mn = fmaxf(m, mx); l *= __builtin_amdgcn_exp2f(m - mn); m = mn;
        float sum = 0.f;
#pragma unroll
        for (int r = 0; r < 16; ++r) sum += __builtin_amdgcn_exp2f(s0[r] - m) + __builtin_amdgcn_exp2f(s1[r] - m);
        l += sum;
        if (t + 1 < nt) stage_store<64, 64>(sr, lds + ((t + 1) & 1) * CSTG, tid);
        __syncthreads();
    }
    const float inv = (m > -1e29f) ? 1.f / xh_sum(l) : 0.f;
    f32x16 o[2];
#pragma unroll
    for (int r = 0; r < 16; ++r) { o[0][r] = 0.f; o[1][r] = 0.f; }
    LAS float* prow = (LAS float*)(lds + C_PROW) + (wid * 32 + l31) * 68;
    float* impg = (float*)(P.ws + WS_ACMP) + (size_t)((b * 2 + g) * 128) * S + q0;
    float carry = 0.f;
    stage_load<64, 64>(sr, src, 0, tid); stage_store<64, 64>(sr, lds, tid); __syncthreads();
    for (int t = 0; t <= nt; ++t) {
        if (t > 0) {
            const LAS float* ih = (const LAS float*)(lds + C_IMPH) + ((t - 1) & 1) * 4096; const int q = tid & 63, nb = (tid >> 6) * 2;
            f32x2 a = *(const LAS f32x2*)(ih + q * 16 + nb); a += *(const LAS f32x2*)(ih + 1024 + q * 16 + nb); a += *(const LAS f32x2*)(ih + 2048 + q * 16 + nb); a += *(const LAS f32x2*)(ih + 3072 + q * 16 + nb);
            impg[(size_t)(16 * (t - 1) + nb) * S + q] = a.x; impg[(size_t)(16 * (t - 1) + nb + 1) * S + q] = a.y;
        }
        if (t == nt) break;
        if (t + 1 < nt) stage_load<64, 64>(sr, src, 64 * (t + 1), tid);
        const LAS char* buf = lds + (t & 1) * CSTG;
        f32x16 s0, s1; qk_tile<64>(s0, s1, buf, qf, koff);
        const int dql = qpos - 31 - 1024 * t - 128 * hi;
        score_fix<M_CMP, true>(s0, s1, c2, slope2, dql, 1024 * t + 1039 > q0w, true);
#pragma unroll
        for (int r = 0; r < 16; ++r) { s0[r] = __builtin_amdgcn_exp2f(s0[r] - m) * inv; s1[r] = __builtin_amdgcn_exp2f(s1[r] - m) * inv; }
        bf16x8 pf[4]; pack_p(pf, s0, s1);
        { bf16x8 v0[4]; v_load4(v0, buf, voff, 0); pv_tile<64>(o, buf, pf, voff, v0); }
        if (t > 0) carry = prow[63];
#pragma unroll
        for (int j = 0; j < 2; ++j) {
            *(LAS f32x4*)(prow + 16 * j + 8 * hi) = (f32x4){s0[8 * j], s0[8 * j + 1], s0[8 * j + 2], s0[8 * j + 3]}; *(LAS f32x4*)(prow + 16 * j + 8 * hi + 4) = (f32x4){s0[8 * j + 4], s0[8 * j + 5], s0[8 * j + 6], s0[8 * j + 7]};
            *(LAS f32x4*)(prow + 32 + 16 * j + 8 * hi) = (f32x4){s1[8 * j], s1[8 * j + 1], s1[8 * j + 2], s1[8 * j + 3]}; *(LAS f32x4*)(prow + 32 + 16 * j + 8 * hi + 4) = (f32x4){s1[8 * j + 4], s1[8 * j + 5], s1[8 * j + 6], s1[8 * j + 7]}; }
        asm volatile("s_waitcnt lgkmcnt(0)" ::: "memory");
        {
            float prev = hi ? prow[31] : carry; float iv[8];
#pragma unroll
            for (int k = 0; k < 8; ++k) { const f32x4 p4 = *(const LAS f32x4*)(prow + 32 * hi + 4 * k); iv[k] = 0.5f * prev + p4[0] + p4[1] + p4[2] + 0.5f * p4[3]; prev = p4[3]; }
            LAS float* ih = (LAS float*)(lds + C_IMPH) + (t & 1) * 4096 + hh * 1024 + (32 * qs + l31) * 16 + 8 * hi;
            *(LAS f32x4*)ih = (f32x4){iv[0], iv[1], iv[2], iv[3]}; *(LAS f32x4*)(ih + 4) = (f32x4){iv[4], iv[5], iv[6], iv[7]};
        }
        if (t + 1 < nt) stage_store<64, 64>(sr, lds + ((t + 1) & 1) * CSTG, tid);
        __syncthreads();
    }
    for (int i = tid; i < 64 * (128 - 16 * nt); i += 512) { const int q = i & 63, n = 16 * nt + (i >> 6); impg[(size_t)n * S + q] = 0.f; }
    float* oc = (float*)(P.dob + DO_OC) + (size_t)(b * S + qpos) * 512 + h * 64;
#pragma unroll
    for (int blk = 0; blk < 2; ++blk)
#pragma unroll
        for (int rr = 0; rr < 4; ++rr) *(f32x4*)(oc + 32 * blk + 8 * rr + 4 * hi) = (f32x4){o[blk][4 * rr], o[blk][4 * rr + 1], o[blk][4 * rr + 2], o[blk][4 * rr + 3]};
    __syncthreads();
}
constexpr int UKSB = 528, USTG = 64 * UKSB;
DI void upproj_unit(const Ptrs& P, int rb, int j, LAS char* lds, int tid, int lane, int wid) {
    asm volatile("" : "+v"(tid), "+v"(lane));
    const int l31 = lane & 31, hi = lane >> 5; const size_t row = (size_t)rb * 256 + wid * 32 + l31;
    const int koff = pi_row(l31) * UKSB + hi * 16;
    const bf16* WQ = (const bf16*)(P.ws + WS_WUQ); const bf16* WKV = (const bf16*)(P.ws + WS_WUKV);
    bf16x8 qf[16]; int have = -1;
    u32x4 sr[4];
#define UP_TILE(i, SRC, NT) const int SRC = (j == 0) ? ((i) < 12 ? 0 : 1) : 1; const int NT = (j == 0) ? ((i) < 12 ? (i) : (i) - 12) : (i) + 2
#define UP_LOAD(i) { UP_TILE(i, s_, n_); const char* wt = (const char*)((s_ ? WKV : WQ) + (size_t)n_ * 64 * 256); _Pragma("unroll") for (int c = 0; c < 4; ++c) sr[c] = *(const u32x4*)(wt + (size_t)(tid + 512 * c) * 16); }
#define UP_STORE(buf) { _Pragma("unroll") for (int c = 0; c < 4; ++c) { const int ch = tid + 512 * c; *(LAS u32x4*)((buf) + (ch >> 5) * UKSB + (ch & 31) * 16) = sr[c]; } }
    UP_LOAD(0); UP_STORE(lds); __syncthreads();
    for (int i = 0; i < 14; ++i) {
        UP_TILE(i, src, nt);
        if (i + 1 < 14) UP_LOAD(i + 1);
        if (src != have) { const bf16* A = (const bf16*)(P.ws + (src ? WS_KVLN : WS_QLN)) + row * 256 + hi * 8;
#pragma unroll
            for (int d0 = 0; d0 < 16; ++d0) qf[d0] = *(const bf16x8*)(A + d0 * 16);
            have = src; }
        const LAS char* buf = lds + (i & 1) * USTG;
        f32x16 s0, s1;
#pragma unroll
        for (int r = 0; r < 16; ++r) { s0[r] = 0.f; s1[r] = 0.f; }
        bf16x8 f0 = *(const LAS bf16x8*)(buf + koff), f1 = *(const LAS bf16x8*)(buf + koff + 32 * UKSB);
#pragma unroll
        for (int d0 = 0; d0 < 16; ++d0) { bf16x8 n0 = f0, n1 = f1;
            if (d0 + 1 < 16) { n0 = *(const LAS bf16x8*)(buf + koff + (d0 + 1) * 32); n1 = *(const LAS bf16x8*)(buf + koff + 32 * UKSB + (d0 + 1) * 32); }
            s0 = MFMA32(f0, qf[d0], s0); s1 = MFMA32(f1, qf[d0], s1); f0 = n0; f1 = n1; }
        bf16x8 pf[4]; pack_p(pf, s0, s1);
        bf16* orow = (bf16*)(P.ws + (src ? WS_KV : WS_QRAW)) + row * (src ? 1024 : 768) + nt * 64 + 8 * hi;
        *(bf16x8*)(orow) = pf[0]; *(bf16x8*)(orow + 16) = pf[1]; *(bf16x8*)(orow + 32) = pf[2]; *(bf16x8*)(orow + 48) = pf[3];
        if (i + 1 < 14) UP_STORE(lds + ((i + 1) & 1) * USTG);
        __syncthreads();
    }
#undef UP_TILE
#undef UP_LOAD
#undef UP_STORE
}

DI void transpose_item(const float* W, int K, int N, int Npad, bf16* WT, int row_off, LAS float* scr, int item, int lane) {
    const int nblk = Npad / 32, kb = item / nblk, nb = item % nblk, k0 = 64 * kb, n0 = 32 * nb; const int nn = n0 + (lane & 31); const bool okn = nn < N;
#pragma unroll 8
    for (int i = 0; i < 32; ++i) { const int kk = 2 * i + (lane >> 5); scr[kk * 33 + (lane & 31)] = okn ? W[(size_t)(k0 + kk) * N + nn] : 0.f; }
    asm volatile("s_waitcnt lgkmcnt(0)" ::: "memory");
    const int c = lane & 7;
#pragma unroll
    for (int j = 0; j < 4; ++j) { const int n = (lane >> 3) + 8 * j; const LAS float* s = scr + (8 * c) * 33 + n;
        u32x4 o; o.x = pk2(s[0 * 33], s[1 * 33]); o.y = pk2(s[2 * 33], s[3 * 33]); o.z = pk2(s[4 * 33], s[5 * 33]); o.w = pk2(s[6 * 33], s[7 * 33]);
        *(u32x4*)(WT + (size_t)(row_off + n0 + n) * K + k0 + 8 * c) = o; }
    asm volatile("s_waitcnt lgkmcnt(0)" ::: "memory");
}
DI void wave_transpose64(const bf16* src, size_t pitch, bf16* dst_row, int lane) {
    unsigned w[32];
#pragma unroll
    for (int k = 0; k < 32; ++k) { const unsigned a = src[(size_t)(2 * k) * pitch + lane], b = src[(size_t)(2 * k + 1) * pitch + lane]; w[k] = a | (b << 16); }
#pragma unroll
    for (int k = 0; k < 8; ++k) *(u32x4*)(dst_row + 8 * k) = (u32x4){w[4 * k], w[4 * k + 1], w[4 * k + 2], w[4 * k + 3]};
}
template <bool FINAL> DI void ln_row(const float* zrow, const float* g, const float* b, bf16* xn, float* st, float* outrow, int lane) {
    f32x4 v[4]; float s = 0.f;
#pragma unroll
    for (int j = 0; j < 4; ++j) { v[j] = *(const f32x4*)(zrow + 256 * j + 4 * lane); s += (v[j].x + v[j].y) + (v[j].z + v[j].w); }
    const float mean = wave_sum(s) * (1.f / 1024.f); float s2 = 0.f;
#pragma unroll
    for (int j = 0; j < 4; ++j) { v[j] = v[j] - mean; s2 += (v[j].x * v[j].x + v[j].y * v[j].y) + (v[j].z * v[j].z + v[j].w * v[j].w); }
    const float rstd = 1.f / sqrtf(wave_sum(s2) * (1.f / 1024.f) + LN_EPS);
#pragma unroll
    for (int j = 0; j < 4; ++j) { const f32x4 gv = *(const f32x4*)(g + 256 * j + 4 * lane), bv = *(const f32x4*)(b + 256 * j + 4 * lane); const f32x4 o = v[j] * rstd * gv + bv;
        if (FINAL) *(f32x4*)(outrow + 256 * j + 4 * lane) = o; else { u32x2 w; w.x = pk2(o.x, o.y); w.y = pk2(o.z, o.w); *(u32x2*)(xn + 256 * j + 4 * lane) = w; } }
    if (!FINAL) { if (lane == 0) { st[0] = mean; st[1] = rstd; } }
}
template <bool FINAL> DI void ln_rows4(const float* z, size_t m0, size_t stride, const float* g, const float* b, bf16* xn, float* st, float* out, int lane) {
    f32x4 v[4][4]; float mean[4], rstd[4];
#pragma unroll
    for (int r = 0; r < 4; ++r)
#pragma unroll
        for (int j = 0; j < 4; ++j) v[r][j] = *(const f32x4*)(z + (m0 + r * stride) * D + 256 * j + 4 * lane);
#pragma unroll
    for (int r = 0; r < 4; ++r) { float s = 0.f;
#pragma unroll
        for (int j = 0; j < 4; ++j) s += (v[r][j].x + v[r][j].y) + (v[r][j].z + v[r][j].w);
        mean[r] = s; }
#pragma unroll
    for (int o = 1; o < 64; o <<= 1) {
#pragma unroll
        for (int r = 0; r < 4; ++r) mean[r] += __shfl_xor(mean[r], o); }
#pragma unroll
    for (int r = 0; r < 4; ++r) { mean[r] *= (1.f / 1024.f); float s2 = 0.f;
#pragma unroll
        for (int j = 0; j < 4; ++j) { v[r][j] = v[r][j] - mean[r]; s2 += (v[r][j].x * v[r][j].x + v[r][j].y * v[r][j].y) + (v[r][j].z * v[r][j].z + v[r][j].w * v[r][j].w); }
        rstd[r] = s2; }
#pragma unroll
    for (int o = 1; o < 64; o <<= 1) {
#pragma unroll
        for (int r = 0; r < 4; ++r) rstd[r] += __shfl_xor(rstd[r], o); }
#pragma unroll
    for (int r = 0; r < 4; ++r) rstd[r] = 1.f / sqrtf(rstd[r] * (1.f / 1024.f) + LN_EPS);
#pragma unroll
    for (int j = 0; j < 4; ++j) { const f32x4 gv = *(const f32x4*)(g + 256 * j + 4 * lane), bv = *(const f32x4*)(b + 256 * j + 4 * lane);
#pragma unroll
        for (int r = 0; r < 4; ++r) { const f32x4 o = v[r][j] * rstd[r] * gv + bv; const size_t row = m0 + r * stride;
            if (FINAL) *(f32x4*)(out + row * D + 256 * j + 4 * lane) = o; else { u32x2 w; w.x = pk2(o.x, o.y); w.y = pk2(o.z, o.w); *(u32x2*)(xn + row * D + 256 * j + 4 * lane) = w; } } }
    if (!FINAL) { if (lane < 4) { const int r = lane; const float mm = (r == 0) ? mean[0] : (r == 1) ? mean[1] : (r == 2) ? mean[2] : mean[3], rr = (r == 0) ? rstd[0] : (r == 1) ? rstd[1] : (r == 2) ? rstd[2] : rstd[3];
        *(f32x2*)(st + 2 * (m0 + r * stride)) = (f32x2){mm, rr}; } }
}
DI void sincos_d(double a, float& c, float& s) {
    const double TWO_PI = 6.283185307179586476925286766559; const double k = __builtin_rint(a / TWO_PI); double r = a - k * TWO_PI;
    const double r2 = r * r; double cs = 1.0, sn = r, tc = 1.0, ts = r;
#pragma unroll 1
    for (int i = 1; i <= 14; ++i) { tc = -tc * r2 / (double)((2 * i - 1) * (2 * i)); ts = -ts * r2 / (double)((2 * i) * (2 * i + 1)); cs += tc; sn += ts; }
    c = (float)cs; s = (float)sn;
}

struct Args { const float* in[32]; float* out; unsigned char* ws; int ph_lo, ph_hi; };
constexpr int NPHASE = 22;
constexpr int XB_LDS_OFF = LDS_BYTES - 128;
#ifndef REP_ATT
#define REP_ATT 1
#endif
#ifndef REP_GEMM
#define REP_GEMM 1
#endif
#ifndef REP_MISC
#define REP_MISC 1
#endif
#define RA for (int rep_ = 0; rep_ < REP_ATT; ++rep_)
#define RG for (int rep_ = 0; rep_ < REP_GEMM; ++rep_)
#define RM for (int rep_ = 0; rep_ < REP_MISC; ++rep_)

#define GEMM_PHASE(EPI, Aptr, Bptr, M_, N_, K_, ...) do { pg8::Gemm g_{(const pg8::bf16_t*)(Aptr), (const pg8::bf16_t*)(Bptr), (M_), (N_), (K_)}; pg8::StaticOrder S_; S_.init((M_), (N_), G, bid); \
    EPI E_{__VA_ARGS__}; pg8::gemm_phase<EPI, pg8::StaticOrder, true, true>(lds, g_, S_, E_); } while (0)

__global__ void __launch_bounds__(512, 2) mega_fwd(Args args) {
    extern __shared__ __attribute__((aligned(16))) unsigned char lds_raw[];
    LAS unsigned char* lds = (LAS unsigned char*)lds_raw;
    cg::grid_group grid = cg::this_grid();
    const int tid = threadIdx.x, lane = tid & 63, wid = __builtin_amdgcn_readfirstlane(tid >> 6), G = gridDim.x, bid = blockIdx.x;
    const int vcu = vcu_of(bid, G), gw = vcu * 8 + wid, NGW = G * 8;
    Ptrs P;
#pragma unroll
    for (int i = 0; i < 32; ++i) P.in[i] = args.in[i];
    P.out = args.out; P.ws = args.ws; P.dob = (unsigned char*)args.out;
    unsigned char* ws = args.ws; unsigned char* dob = P.dob;
    const int lo = args.ph_lo, hi_ph = args.ph_hi;
#define IN(k) (lo <= (k) && (k) < hi_ph)
#define SEAM(k) do { if (IN(k) && IN((k) + 1)) { if ((k) == 0) grid.sync(); else xcd_barrier(xbar); } } while (0)
    { volatile LAS unsigned* stw = (volatile LAS unsigned*)(lds + XB_LDS_OFF); if (tid == 0) { stw[0] = 0u; stw[1] = 0u; } __syncthreads(); }
    XcdBarrier xbar = xcd_barrier_post((unsigned*)(ws + WS_CTL), (volatile LAS unsigned*)(lds + XB_LDS_OFF));
    float* stats = (float*)(ws + WS_STATS);
    bf16* Hb = (bf16*)(ws + WS_H); bf16* XB = (bf16*)(ws + WS_XB);

#ifdef PROBE_SYNCS
    if (lo == 0) { for (int i_ = 0; i_ < PROBE_SYNCS; ++i_) grid.sync(); }
#endif
    if (IN(0)) RM {
        LAS float* scr = (LAS float*)(lds + wid * 16384);
        constexpr int I0 = 16 * 64, I1 = 4 * 24, I2 = 4 * 32, I3 = 32 * 2, I4 = 32 * 2, I5 = 32 * 4, I6 = 16 * 32, I7 = 16 * 128, I8 = 64 * 32, I9 = 16 * 96, I10 = 16 * 32, I11 = 16 * 128, I12 = 64 * 32;
        constexpr int NIT = I0 + I1 + I2 + I3 + I4 + I5 + I6 + I7 + I8 + I9 + I10 + I11 + I12;
        for (int it = gw; it < NIT; it += NGW) { int r = it;
            if (r < I0) { transpose_item(P.in[1], 1024, L0W, 2048, (bf16*)(ws + WS_WIN), 0, scr, r, lane); continue; } r -= I0;
            if (r < I1) { transpose_item(P.in[3], 256, 768, 768, (bf16*)(ws + WS_WUQ), 0, scr, r, lane); continue; } r -= I1;
            if (r < I2) { transpose_item(P.in[5], 256, 1024, 1024, (bf16*)(ws + WS_WUKV), 0, scr, r, lane); continue; } r -= I2;
            if (r < I3) { transpose_item(P.in[7], 2048, 64, 64, (bf16*)(ws + WS_W1), 0, scr, r, lane); continue; } r -= I3;
            if (r < I4) { transpose_item(P.in[10], 2048, 64, 64, (bf16*)(ws + WS_W1), 64, scr, r, lane); continue; } r -= I4;
            if (r < I5) { transpose_item(P.in[7], 2048, 0, 128, (bf16*)(ws + WS_W1), 128, scr, r, lane); continue; } r -= I5;
            if (r < I6) { transpose_item(P.in[12], 1024, 1024, 1024, (bf16*)(ws + WS_WOUT), 0, scr, r, lane); continue; } r -= I6;
            if (r < I7) { transpose_item(P.in[15], 1024, 4096, 4096, (bf16*)(ws + WS_WUP0), 0, scr, r, lane); continue; } r -= I7;
            if (r < I8) { transpose_item(P.in[16], 4096, 1024, 1024, (bf16*)(ws + WS_WDN0), 0, scr, r, lane); continue; } r -= I8;
            if (r < I9) { transpose_item(P.in[19], 1024, 3072, 3072, (bf16*)(ws + WS_WQKV), 0, scr, r, lane); continue; } r -= I9;
            if (r < I10) { transpose_item(P.in[25], 1024, 1024, 1024, (bf16*)(ws + WS_WO), 0, scr, r, lane); continue; } r -= I10;
            if (r < I11) { transpose_item(P.in[28], 1024, 4096, 4096, (bf16*)(ws + WS_WUP1), 0, scr, r, lane); continue; } r -= I11;
            transpose_item(P.in[29], 4096, 1024, 1024, (bf16*)(ws + WS_WDN1), 0, scr, r, lane);
        }
        for (int m = gw; m < T; m += 4 * NGW) { f32x4 v[4][4];
#pragma unroll
            for (int r = 0; r < 4; ++r)
#pragma unroll
                for (int j = 0; j < 4; ++j) v[r][j] = *(const f32x4*)(P.in[0] + (size_t)(m + r * NGW) * D + 256 * j + 4 * lane);
#pragma unroll
            for (int r = 0; r < 4; ++r)
#pragma unroll
                for (int j = 0; j < 4; ++j) { u32x2 w; w.x = pk2(v[r][j].x, v[r][j].y); w.y = pk2(v[r][j].z, v[r][j].w); *(u32x2*)(XB + (size_t)(m + r * NGW) * D + 256 * j + 4 * lane) = w; } }
        { const float INV[16] = {1.f, 0.562341332f, 0.316227764f, 0.177827939f, 0.100000001f, 0.0562341288f, 0.0316227786f, 0.0177827943f, 0.00999999978f, 0.00562341325f, 0.00316227786f, 0.00177827943f, 0.00100000005f, 0.000562341302f, 0.000316227786f, 0.00017782794f};
          f32x2* rope = (f32x2*)(dob + DO_ROPE);
          for (int idx = bid * 512 + tid; idx < S * 16; idx += G * 512) { const int i = idx & 15, t = idx >> 4; float inv = INV[0];
#pragma unroll
              for (int k = 1; k < 16; ++k) inv = (i == k) ? INV[k] : inv;
              const float ang = (float)t * inv; float c, s; sincos_d((double)ang, c, s); rope[idx] = (f32x2){c, s}; } }
    }
    SEAM(0);
    if (IN(1)) RG GEMM_PHASE(pg8::EpiB16<0>, XB, ws + WS_WIN, T, HW, D, Hb, HW);
    SEAM(1);
    if (IN(2)) RM {
        const f32x2* rope = (const f32x2*)(dob + DO_ROPE);
        LAS unsigned* knl = (LAS unsigned*)lds;
        if (tid < 16) knl[tid] = 0u;
        __syncthreads();
        for (int row = gw; row < T; row += NGW) { const bf16* hr = Hb + (size_t)row * HW; const int t = row & (S - 1);
            { const float a0 = bf2f(hr[C_KS + lane]), a1 = bf2f(hr[C_KS + 64 + lane]), b0 = bf2f(hr[C_KW + lane]), b1 = bf2f(hr[C_KW + 64 + lane]);
              const float n0 = wave_sum(a0 * a0), n1 = wave_sum(a1 * a1), n2 = wave_sum(b0 * b0), n3 = wave_sum(b1 * b1); const int bb = row >> 13;
              if (lane == 0) { __hip_atomic_fetch_max(&knl[bb * 2], __builtin_bit_cast(unsigned, n0), __ATOMIC_RELAXED, __HIP_MEMORY_SCOPE_WORKGROUP); __hip_atomic_fetch_max(&knl[bb * 2 + 1], __builtin_bit_cast(unsigned, n1), __ATOMIC_RELAXED, __HIP_MEMORY_SCOPE_WORKGROUP); __hip_atomic_fetch_max(&knl[8 + bb * 2], __builtin_bit_cast(unsigned, n2), __ATOMIC_RELAXED, __HIP_MEMORY_SCOPE_WORKGROUP); __hip_atomic_fetch_max(&knl[8 + bb * 2 + 1], __builtin_bit_cast(unsigned, n3), __ATOMIC_RELAXED, __HIP_MEMORY_SCOPE_WORKGROUP); } }
#pragma unroll
            for (int which = 0; which < 2; ++which) { const u32x2 w = *(const u32x2*)(hr + which * 256 + 4 * lane); const float x0 = bf2f(w.x & 0xffffu), x1 = bf2f(w.x >> 16), x2 = bf2f(w.y & 0xffffu), x3 = bf2f(w.y >> 16);
                const float ss = wave_sum(x0 * x0 + x1 * x1 + x2 * x2 + x3 * x3); const float r = 1.f / sqrtf(ss * (1.f / 256.f) + RMS_EPS);
                const f32x4 gn = *(const f32x4*)(P.in[which ? 4 : 2] + 4 * lane); u32x2 o; o.x = pk2(x0 * r * gn.x, x1 * r * gn.y); o.y = pk2(x2 * r * gn.z, x3 * r * gn.w);
                *(u32x2*)((bf16*)(ws + (which ? WS_KVLN : WS_QLN)) + (size_t)row * 256 + 4 * lane) = o; }
            if (lane < 16) { const float x1 = bf2f(hr[C_KROPE + lane]), x2 = bf2f(hr[C_KROPE + 16 + lane]); const f32x2 cs = rope[t * 16 + lane]; bf16* kp = (bf16*)(dob + DO_KPE) + (size_t)row * 32;
                kp[lane] = (bf16)f2bf(x1 * cs.x - x2 * cs.y); kp[16 + lane] = (bf16)f2bf(x1 * cs.y + x2 * cs.x); }
            if (lane < 24) { const float v = bf2f(hr[C_GATE + lane]); ((float*)(dob + DO_GATE))[(size_t)row * 24 + lane] = 1.f / (1.f + __expf(-v)); }
        }
        for (int r = gw; r < 8192; r += NGW) { const int kv = r >> 12, rr = r & 4095, g = rr & 1, bi = rr >> 1, b = bi >> 9, i = bi & 511; bf16* dst = (bf16*)(ws + WS_ACMP) + (size_t)r * 2048;
            const float* pos = P.in[kv ? 9 : 6]; const int cb = (kv ? C_VC : C_KC) + g * 64;
#pragma unroll
            for (int it = 0; it < 8; ++it) { const int l = it * 4 + (lane >> 4), d4 = (lane & 15) * 4; u32x2 o = {0u, 0u};
                if (i < 511) { const u32x2 w = *(const u32x2*)(Hb + (size_t)(b * S + 16 * i + l) * HW + cb + d4); const f32x4 pv = *(const f32x4*)(pos + l * 64 + d4);
                    o.x = pk2(bf2f(w.x & 0xffffu) + pv.x, bf2f(w.x >> 16) + pv.y); o.y = pk2(bf2f(w.y & 0xffffu) + pv.z, bf2f(w.y >> 16) + pv.w); }
                *(u32x2*)(dst + l * 64 + d4) = o; } }
        for (int it = gw; it < 2048; it += NGW) { const int which = it >> 10, r = it & 1023, bg = r >> 7, tb = r & 127, b = bg >> 1, g = bg & 1;
            wave_transpose64(Hb + (size_t)(b * S + tb * 64) * HW + (which ? C_VW : C_VS) + g * 64, HW, (bf16*)(ws + (which ? WS_VTW : WS_VTS)) + (size_t)(bg * 64 + lane) * S + tb * 64, lane); }
        __syncthreads();
        if (tid < 16) atomicMax((unsigned*)(ws + WS_CTL) + KN_WORD + 64 + tid, knl[tid]);
    }
    SEAM(2);
    if (IN(3)) {
        GEMM_PHASE(pg8::EpiF32<3>, ws + WS_ACMP, ws + WS_W1, 8192, 256, 2048, (float*)(dob + DO_CH), 256);
        { unsigned* qc = (unsigned*)(ws + WS_CTL) + 3703; volatile LAS int* qs = (volatile LAS int*)(lds + LDS_BYTES - 256);
          for (;;) { __syncthreads(); if (tid == 0) *qs = (int)atomicAdd(qc, 1u); __syncthreads(); const int e = *qs; if (e >= 256) break;
              upproj_unit(P, e >> 1, e & 1, (LAS char*)lds, tid, lane, wid); } }
    }
    SEAM(3);
    if (IN(4)) RM {
        for (int r = gw; r < 8192; r += NGW) { const int kv = r >> 12, rr = r & 4095, g = rr & 1, bi = rr >> 1, b = bi >> 9, i = bi & 511;
            const float* ch = (const float*)(dob + DO_CH) + (size_t)r * 256 + kv * 64; const float* w2 = P.in[kv ? 11 : 8]; float acc = 0.f;
#pragma unroll 8
            for (int c = 0; c < 64; ++c) acc = __builtin_fmaf(ch[c], w2[c * 64 + lane], acc);
            if (kv == 0) ((bf16*)(dob + DO_KC))[(size_t)((b * 2 + g) * 512 + i) * 64 + lane] = (bf16)f2bf(acc);
            else ((bf16*)(dob + DO_VCT))[(size_t)((b * 2 + g) * 64 + lane) * 512 + i] = (bf16)f2bf(acc); }
        for (int it = gw; it < 4096; it += NGW) { const int bh = it >> 7, tb = it & 127, b = bh >> 3, h = bh & 7;
            wave_transpose64((const bf16*)(ws + WS_KV) + (size_t)(b * S + tb * 64) * 1024 + h * 128 + 64, 1024, (bf16*)(ws + WS_QLN) + (size_t)(bh * 64 + lane) * S + tb * 64, lane); }
    }
    SEAM(4);
    if (IN(5)) RA {
        for (int p = vcu; p < 512; p += G) { const int bh = p >> 4, s = p & 15; mla_unit(P, bh >> 3, bh & 7, 31 - s, (LAS char*)lds, tid, lane, wid); mla_unit(P, bh >> 3, bh & 7, s, (LAS char*)lds, tid, lane, wid); }
        for (int u = vcu; u < 1024; u += G) { const int bg = u & 7, qblk = u >> 3; cmp_unit(P, bg >> 1, bg & 1, qblk, (LAS char*)lds, tid, lane, wid); }
    }
    SEAM(5);
    if (IN(6)) RM {
        const float* imp = (const float*)(ws + WS_ACMP); unsigned* selm = (unsigned*)(dob + DO_SELM);
        for (int it = gw; it < NB * 2 * S / 64; it += NGW) { const int bg = it >> 7, q = ((it & 127) << 6) + lane, cur = q >> 6; const float* ip = imp + (size_t)(bg * 128) * S + q;
            float w[128];
#pragma unroll
            for (int n = 0; n < 128; ++n) { const float v = ip[(size_t)n * S]; const bool forced = (n == 0 || n == cur || n == cur - 1); w[n] = (n <= cur) ? (forced ? -3.0e38f : v) : NEGF; }
            unsigned m0 = 1u, m1 = 0u, m2 = 0u, m3 = 0u;
            { const unsigned bc = 1u << (cur & 31); const int wc_ = cur >> 5; m0 |= (wc_ == 0) ? bc : 0u; m1 |= (wc_ == 1) ? bc : 0u; m2 |= (wc_ == 2) ? bc : 0u; m3 |= (wc_ == 3) ? bc : 0u;
              const int cp = cur > 0 ? cur - 1 : 0; const unsigned bp = 1u << (cp & 31); const int wp_ = cp >> 5; m0 |= (wp_ == 0) ? bp : 0u; m1 |= (wp_ == 1) ? bp : 0u; m2 |= (wp_ == 2) ? bp : 0u; m3 |= (wp_ == 3) ? bp : 0u; }
#pragma unroll 1
            for (int r = 0; r < 13; ++r) {
                float a = mx3(w[0], w[1], w[2]), c = mx3(w[3], w[4], w[5]);
#pragma unroll
                for (int n = 6; n < 126; n += 4) { a = mx3(a, w[n], w[n + 1]); c = mx3(c, w[n + 2], w[n + 3]); }
                const float mxv = mx3(a, c, fmaxf(w[126], w[127]));
                int idx = 0;
#pragma unroll
                for (int n = 127; n >= 0; --n) idx = (w[n] == mxv) ? n : idx;
#pragma unroll
                for (int n = 0; n < 128; ++n) w[n] = (n == idx) ? -3.0e38f : w[n];
                const unsigned bit = (mxv > -1e29f) ? (1u << (idx & 31)) : 0u; const int wsel = idx >> 5;
                m0 |= (wsel == 0) ? bit : 0u; m1 |= (wsel == 1) ? bit : 0u; m2 |= (wsel == 2) ? bit : 0u; m3 |= (wsel == 3) ? bit : 0u;
            }
            *(u32x4*)(selm + ((size_t)bg * S + q) * 4) = (u32x4){m0, m1, m2, m3}; }
    }
    SEAM(6);
    if (IN(7)) {
        unsigned* qc = (unsigned*)(ws + WS_CTL) + 3700; volatile LAS int* qs = (volatile LAS int*)(lds + LDS_BYTES - 256); int e = vcu;
        while (e < 1024) { int nx = 0; if (tid == 0) nx = 256 + (int)atomicAdd(qc, 1u);
            const int h = 7 - (e >> 7), b = (e >> 5) & 3, qb = e & 31;
            nsa_sw_unit(P, b, h, qb, (LAS char*)lds, tid, lane, wid);
            __syncthreads(); if (tid == 0) *qs = nx; __syncthreads(); e = *qs; }
    }
    SEAM(7);
    if (IN(8)) RG GEMM_PHASE(pg8::EpiResid<0>, XB, ws + WS_WOUT, T, D, D, P.in[0], nullptr, nullptr, nullptr, P.out, ALPHA);
    SEAM(8);
    if (IN(9)) RM { for (int m = gw; m < T; m += 4 * NGW) ln_rows4<false>(P.out, (size_t)m, (size_t)NGW, P.in[13], P.in[14], XB, stats, nullptr, lane); }
    SEAM(9);
    if (IN(10)) RG GEMM_PHASE(pg8::EpiB16<2>, XB, ws + WS_WUP0, T, FF, D, (pg8::bf16_t*)(ws + WS_HID), FF);
    SEAM(10);
    if (IN(11)) RG GEMM_PHASE(pg8::EpiResid<1>, ws + WS_HID, ws + WS_WDN0, T, D, FF, P.out, stats, P.in[13], P.in[14], (float*)(ws + WS_H), ALPHA);
    SEAM(11);
    if (IN(12)) RM { for (int m = gw; m < T; m += 4 * NGW) ln_rows4<false>((const float*)(ws + WS_H), (size_t)m, (size_t)NGW, P.in[17], P.in[18], XB, stats + 2 * (size_t)T, nullptr, lane); }
    SEAM(12);
    if (IN(13)) RG GEMM_PHASE(pg8::EpiB16<0>, XB, ws + WS_WQKV, T, 3072, D, (pg8::bf16_t*)(ws + WS_QKV), 3072);
    SEAM(13);
    if (IN(14)) RM { for (int it = gw; it < 8192; it += NGW) { const int half = it & 1, r = it >> 1, bh = r >> 7, tb = r & 127, b = bh >> 3, h = bh & 7;
            wave_transpose64((const bf16*)(ws + WS_QKV) + (size_t)(b * S + tb * 64) * 3072 + 2048 + h * 128 + half * 64, 3072, (bf16*)(ws + WS_VTD) + (size_t)(bh * 128 + half * 64 + lane) * S + tb * 64, lane); }
        for (int it = gw; it < 8192; it += NGW) { const int bhj = it >> 7, tb = it & 127, b = bhj >> 4, h = (bhj >> 1) & 7, j = bhj & 1;
            const bf16* kr = (const bf16*)(ws + WS_QKV) + (size_t)(b * S + tb * 64 + lane) * 3072 + 1024 + h * 128 + j * 64; float ss = 0.f;
#pragma unroll
            for (int c = 0; c < 8; ++c) { const u32x4 w = *(const u32x4*)(kr + 8 * c);
#pragma unroll
                for (int e = 0; e < 4; ++e) { const float x0 = bf2f(w[e] & 0xffffu), x1 = bf2f(w[e] >> 16); ss += x0 * x0 + x1 * x1; } }
#pragma unroll
            for (int o = 1; o < 64; o <<= 1) ss = fmaxf(ss, __shfl_xor(ss, o));
            if (lane == 0) atomicMax((unsigned*)(ws + WS_CTL) + KN_WORD + bhj, __builtin_bit_cast(unsigned, ss)); }
    }
    SEAM(14);
    if (IN(15)) {
        unsigned* qc = (unsigned*)(ws + WS_CTL) + 3701; volatile LAS int* qs = (volatile LAS int*)(lds + LDS_BYTES - 256); int e = vcu;
        while (e < 2048) { int nx = 0; if (tid == 0) nx = 256 + (int)atomicAdd(qc, 1u);
            const int h = 7 - (e >> 8), bj = (e >> 5) & 7, b = bj >> 1, j = bj & 1, qb = 31 - (e & 31);
            diff_unit(P, b, h, j, qb, (LAS char*)lds, tid, lane, wid);
            __syncthreads(); if (tid == 0) *qs = nx; __syncthreads(); e = *qs; }
    }
    SEAM(15);
    if (IN(16)) RM {
        const float a1 = wave_sum(P.in[20][lane] * P.in[21][lane]), a2 = wave_sum(P.in[22][lane] * P.in[23][lane]); const float lam = __expf(a1) - __expf(a2) + LAM_INIT;
        const bf16* OD = (const bf16*)dob; const int hh = lane >> 3, e0 = (lane & 7) * 16;
        for (int m0 = gw; m0 < T; m0 += 4 * NGW) { u32x4 w1[4][2], w2[4][2];
#pragma unroll
            for (int r = 0; r < 4; ++r) { const bf16* o1 = OD + (size_t)(m0 + r * NGW) * 2048 + hh * 256 + e0;
#pragma unroll
                for (int c = 0; c < 2; ++c) { w1[r][c] = *(const u32x4*)(o1 + 8 * c); w2[r][c] = *(const u32x4*)(o1 + 128 + 8 * c); } }
#pragma unroll
            for (int r = 0; r < 4; ++r) { const int m = m0 + r * NGW; float v[16]; float ss = 0.f;
#pragma unroll
                for (int c = 0; c < 2; ++c)
#pragma unroll
                    for (int e = 0; e < 4; ++e) { v[8 * c + 2 * e] = bf2f(w1[r][c][e] & 0xffffu) - lam * bf2f(w2[r][c][e] & 0xffffu); v[8 * c + 2 * e + 1] = bf2f(w1[r][c][e] >> 16) - lam * bf2f(w2[r][c][e] >> 16); }
#pragma unroll
                for (int e = 0; e < 16; ++e) ss += v[e] * v[e];
                ss += __shfl_xor(ss, 1); ss += __shfl_xor(ss, 2); ss += __shfl_xor(ss, 4);
                const float rr = (1.f - LAM_INIT) / sqrtf(ss * (1.f / 128.f) + RMS_EPS); const float* sg = P.in[24] + e0; bf16* dst = XB + (size_t)m * D + hh * 128 + e0;
#pragma unroll
                for (int c = 0; c < 2; ++c) { u32x4 w;
#pragma unroll
                    for (int e = 0; e < 4; ++e) w[e] = pk2(v[8 * c + 2 * e] * rr * sg[8 * c + 2 * e], v[8 * c + 2 * e + 1] * rr * sg[8 * c + 2 * e + 1]);
                    *(u32x4*)(dst + 8 * c) = w; } } }
    }
    SEAM(16);
    if (IN(17)) RG GEMM_PHASE(pg8::EpiResid<1>, XB, ws + WS_WO, T, D, D, (const float*)(ws + WS_H), stats + 2 * (size_t)T, P.in[17], P.in[18], P.out, ALPHA);
    SEAM(17);
    if (IN(18)) RM { for (int m = gw; m < T; m += 4 * NGW) ln_rows4<false>(P.out, (size_t)m, (size_t)NGW, P.in[26], P.in[27], XB, stats + 4 * (size_t)T, nullptr, lane); }
    SEAM(18);
    if (IN(19)) RG GEMM_PHASE(pg8::EpiB16<2>, XB, ws + WS_WUP1, T, FF, D, (pg8::bf16_t*)(ws + WS_HID), FF);
    SEAM(19);
    if (IN(20)) RG GEMM_PHASE(pg8::EpiResid<1>, ws + WS_HID, ws + WS_WDN1, T, D, FF, P.out, stats + 2 * (size_t)(2 * T), P.in[26], P.in[27], (float*)(ws + WS_H), ALPHA);
    SEAM(20);
    if (IN(21)) RM { for (int m = gw; m < T; m += 4 * NGW) ln_rows4<true>((const float*)(ws + WS_H), (size_t)m, (size_t)NGW, P.in[30], P.in[31], nullptr, nullptr, P.out, lane); }
#undef IN
#undef SEAM
}

extern "C" void kernel_launch(void* const* d_in, const int* in_sizes, int n_in, void* d_out, int out_size, void* d_ws, size_t ws_size, hipStream_t stream) {
    static int grid = 0;
    if (grid == 0) {
        if (n_in != 32 || out_size != T * D || ws_size < WS_CTL + 16384) { fprintf(stderr, "kernel_launch: unexpected shapes (n_in %d out %d ws %zu)\n", n_in, out_size, ws_size); grid = -1; return; }
        int dev = 0, cus = 0, per_cu = 0;
        hipGetDevice(&dev); hipDeviceGetAttribute(&cus, hipDeviceAttributeMultiprocessorCount, dev);
        hipFuncSetAttribute((const void*)mega_fwd, hipFuncAttributeMaxDynamicSharedMemorySize, LDS_BYTES);
        hipOccupancyMaxActiveBlocksPerMultiprocessor(&per_cu, (const void*)mega_fwd, 512, LDS_BYTES);
        if (per_cu < 1) { fprintf(stderr, "kernel_launch: occupancy query says %d blocks per CU\n", per_cu); per_cu = 1; }
        (void)hipGetLastError();
        grid = cus * per_cu;
        if (grid > 256) grid = 256;
        if (grid < 256) { fprintf(stderr, "kernel_launch: only %d co-resident workgroups; this kernel needs 256\n", grid); grid = -1; return; }
    }
    if (grid < 0) return;
    if (hipMemsetAsync((char*)d_ws + WS_CTL, 0, 16384, stream) != hipSuccess) { fprintf(stderr, "kernel_launch: memset failed\n"); return; }
    Args a{};
    for (int i = 0; i < 32; ++i) a.in[i] = (const float*)d_in[i];
    a.out = (float*)d_out; a.ws = (unsigned char*)d_ws;
#ifdef PROBE_SEQ
    static const int seq[][2] = PROBE_SEQ;
    for (unsigned si = 0; si < sizeof(seq) / sizeof(seq[0]); ++si) { const int ph = si; a.ph_lo = seq[si][0]; a.ph_hi = seq[si][1]; void* kargs[] = {&a}; if (si) (void)hipMemsetAsync((char*)d_ws + WS_CTL, 0, 16384, stream);
        hipError_t e = hipLaunchCooperativeKernel((const void*)mega_fwd, dim3(grid), dim3(512), kargs, LDS_BYTES, stream);
        if (e != hipSuccess) { fprintf(stderr, "launch phase %d failed: %s\n", ph, hipGetErrorString(e)); break; } }
#else
    a.ph_lo = 0; a.ph_hi = NPHASE; void* kargs[] = {&a};
    hipError_t e = hipLaunchCooperativeKernel((const void*)mega_fwd, dim3(grid), dim3(512), kargs, LDS_BYTES, stream);
    if (e != hipSuccess) fprintf(stderr, "cooperative launch failed: %s (grid %d)\n", hipGetErrorString(e), grid);
#endif
}
```

```cpp
#include <hip/hip_runtime.h>
#include <hip/hip_cooperative_groups.h>
#include <cstdio>
#include <cstdint>
namespace cg = cooperative_groups;
namespace pg8 {
#define PG8_LAS __attribute__((address_space(3)))
typedef unsigned short bf16_t;
typedef short bf16x8 __attribute__((ext_vector_type(8)));
typedef float f32x4 __attribute__((ext_vector_type(4)));
typedef unsigned u32x4 __attribute__((ext_vector_type(4)));
constexpr int BM = 256, BK = 64, HALF = 128, HTB = HALF * BK * 2  , STAGE_BYTES = 8 * HTB, NXCD = 8, WGM = 8;

__host__ __device__ __forceinline__ int lds_byte(int r, int c) { const int st = (r >> 4) * 2 + (c >> 5), rr = r & 15, cc = c & 31, ob = rr * 64 + cc * 2; return st * 1024 + (ob ^ (((ob >> 9) & 1) << 5)); }
__host__ __device__ __forceinline__ void stage_rc(int b, int& R, int& C) { const int st = b / 1024, sb = b % 1024, swz = sb ^ (((sb >> 9) & 1) << 5); R = (st >> 1) * 16 + swz / 64; C = (st & 1) * 32 + (swz % 64) / 2; }
__host__ __device__ __forceinline__ int perm32(int rho) { const int n = rho >> 4, i = rho & 15; return 8 * (i >> 2) + 4 * n + (i & 3); }

struct Unit { int pm, pn; };
struct Gemm { const bf16_t* A; const bf16_t* Bt; int M, N, K; };

struct StaticOrder {
    int nM, nN, nwg, G, c;
    __host__ __device__ void init(int M, int N, int G_, int c_) { nM = M / BM; nN = N / BM; nwg = nM * nN; G = G_; c = c_; }
    __host__ __device__ bool next(int i, Unit& u) const {
        const long L = (long)i * G + c; if (L >= nwg) return false;
        int wgid = (int)L; { const int q = nwg / NXCD, r = nwg % NXCD, xcd = wgid % NXCD, off = wgid / NXCD; wgid = (xcd < r ? xcd * (q + 1) : r * (q + 1) + (xcd - r) * q) + off; }
        const int nig = WGM * nN, gid = wgid / nig, fm = gid * WGM, gsz = (nM - fm) < WGM ? (nM - fm) : WGM;
        u.pm = fm + ((wgid % nig) % gsz); u.pn = (wgid % nig) / gsz; return true;
    }
    __device__ __forceinline__ void a_ready(const Unit&) const {}
    __device__ __forceinline__ void done(const Unit&) const {}
};

typedef float f32x2 __attribute__((ext_vector_type(2)));
typedef __bf16 bf16x2_t __attribute__((ext_vector_type(2)));
__device__ __forceinline__ unsigned cvt_pk_bf16(float lo, float hi) { f32x2 v = {lo, hi}; bf16x2_t b = __builtin_convertvector(v, bf16x2_t); return __builtin_bit_cast(unsigned, b); }
__device__ __forceinline__ float act_apply(float v, int ACT) {
    if (ACT == 2) { const float r = v > 0.f ? v : 0.f; return r * r; }
    if (ACT == 3) { const float u = 0.7978845608028654f * (v + 0.044715f * v * v * v); const float e = __builtin_amdgcn_exp2f(u * 2.8853900817779268f); const float th = 1.f - 2.f * __builtin_amdgcn_rcpf(e + 1.f); return 0.5f * v * (1.f + th); }
    return v;
}
template <int ACT> struct EpiB16 {
    static constexpr bool PERM = true, AFTER_DRAIN = false;
    bf16_t* O; int ldc;
    __device__ __forceinline__ void operator()(const f32x4 (&acc)[2][2][4][2], const Unit& u, int wr, int wc, int fr, int fq) const {
        const int row0 = u.pm * BM + wr * 64 + fr; const int col0 = u.pn * BM + wc * 32 + 8 * fq;
#pragma unroll
        for (int ai = 0; ai < 2; ++ai)
#pragma unroll
            for (int m = 0; m < 4; ++m) { bf16_t* rowp = O + (size_t)(row0 + ai * HALF + m * 16) * ldc + col0;
#pragma unroll
                for (int bj = 0; bj < 2; ++bj) { f32x4 v0 = acc[ai][bj][m][0], v1 = acc[ai][bj][m][1];
                    if (ACT != 0) {
#pragma unroll
                        for (int e = 0; e < 4; ++e) { v0[e] = act_apply(v0[e], ACT); v1[e] = act_apply(v1[e], ACT); } }
                    u32x4 w; w.x = cvt_pk_bf16(v0[0], v0[1]); w.y = cvt_pk_bf16(v0[2], v0[3]); w.z = cvt_pk_bf16(v1[0], v1[1]); w.w = cvt_pk_bf16(v1[2], v1[3]);
                    *(u32x4*)(rowp + bj * HALF) = w; } }
    }
};
template <int ACT> struct EpiF32 {
    static constexpr bool PERM = false, AFTER_DRAIN = false;
    float* O; int ldc;
    __device__ __forceinline__ void operator()(const f32x4 (&acc)[2][2][4][2], const Unit& u, int wr, int wc, int fr, int fq) const {
        const int row0 = u.pm * BM + wr * 64 + fr; const int col0 = u.pn * BM + wc * 32 + 4 * fq;
#pragma unroll
        for (int ai = 0; ai < 2; ++ai)
#pragma unroll
            for (int m = 0; m < 4; ++m) { float* rowp = O + (size_t)(row0 + ai * HALF + m * 16) * ldc + col0;
#pragma unroll
                for (int bj = 0; bj < 2; ++bj)
#pragma unroll
                    for (int n = 0; n < 2; ++n) { f32x4 v = acc[ai][bj][m][n];
#pragma unroll
                        for (int e = 0; e < 4; ++e) v[e] = act_apply(v[e], ACT);
                        *(f32x4*)(rowp + bj * HALF + n * 16) = v; } }
    }
};
template <int MODE> struct EpiResid {
    static constexpr bool PERM = false, AFTER_DRAIN = false;
    const float* base; const float* stats; const float* g; const float* b; float* out; float alpha;
    __device__ __forceinline__ void operator()(const f32x4 (&acc)[2][2][4][2], const Unit& u, int wr, int wc, int fr, int fq) const {
        const int row0 = u.pm * BM + wr * 64 + fr; const int col0 = u.pn * BM + wc * 32 + 4 * fq;
#pragma unroll
        for (int ai = 0; ai < 2; ++ai)
#pragma unroll
            for (int m = 0; m < 4; ++m) { const int r = row0 + ai * HALF + m * 16; const size_t off = (size_t)r * 1024 + col0;
                float mean = 0.f, rstd = 1.f; if (MODE == 1) { const f32x2 st = *(const f32x2*)(stats + 2 * (size_t)r); mean = st.x; rstd = st.y; }
#pragma unroll
                for (int bj = 0; bj < 2; ++bj)
#pragma unroll
                    for (int n = 0; n < 2; ++n) { f32x4 bs = *(const f32x4*)(base + off + bj * HALF + n * 16);
                        if (MODE == 1) { const f32x4 gv = *(const f32x4*)(g + col0 + bj * HALF + n * 16), bv = *(const f32x4*)(b + col0 + bj * HALF + n * 16); bs = (bs - mean) * rstd * gv + bv; }
                        *(f32x4*)(out + off + bj * HALF + n * 16) = bs * alpha + acc[ai][bj][m][n]; }
                asm volatile("" ::: "memory"); }
    }
};

template <class Epi, class Sched, bool ALIGN_EPI = false, bool SP2 = false>
__device__ __forceinline__ void gemm_phase(PG8_LAS unsigned char* lds, const Gemm g, const Sched& S, const Epi& E) {
    const int tid = threadIdx.x, wid = __builtin_amdgcn_readfirstlane(tid >> 6), lane = tid & 63, wr = wid >> 2, wc = wid & 3, fr = lane & 15, fq = lane >> 4;
    const int K = g.K, nt = K / BK;
    unsigned voffA[2], voffB[2];
#pragma unroll
    for (int i = 0; i < 2; ++i) { int R, C; stage_rc(tid * 16 + i * 8192, R, C); const int Rb = Epi::PERM ? ((R & ~31) + perm32(R & 31)) : R;
        voffA[i] = (unsigned)(R * K + C) * 2u; voffB[i] = (unsigned)(Rb * K + C) * 2u; }
    const size_t kstep = (size_t)(BK * 2);
    const size_t hstep = (size_t)HALF * K * 2;
    const size_t tstep = 2 * hstep;
    const unsigned ldsw = (unsigned)wid * 1024u;
    const int aoff = lds_byte(wr * 64 + fr, fq * 8), boff = lds_byte(wc * 32 + fr, fq * 8);
#define PG8_SA(b, h) (((b) * 2 + (h)) * HTB)
#define PG8_SB(b, h) ((4 + (b) * 2 + (h)) * HTB)
#define PG8_STAGE(bufoff, gbase, voff) do { _Pragma("unroll") for (int _i = 0; _i < 2; ++_i) \
        __builtin_amdgcn_global_load_lds((const unsigned*)((const char*)(gbase) + (voff)[_i]), (PG8_LAS unsigned*)(lds + (bufoff) + ldsw + _i * 8192), 16, 0, 0); } while (0)
#define PG8_LDA(dst, b, h) do { _Pragma("unroll") for (int m = 0; m < 4; ++m) _Pragma("unroll") for (int k = 0; k < 2; ++k) dst[m][k] = *(const PG8_LAS bf16x8*)(lds + PG8_SA(b, h) + aoff + m * 2048 + k * 1024); } while (0)
#define PG8_LDB(dst, b, h) do { _Pragma("unroll") for (int n = 0; n < 2; ++n) _Pragma("unroll") for (int k = 0; k < 2; ++k) dst[n][k] = *(const PG8_LAS bf16x8*)(lds + PG8_SB(b, h) + boff + n * 2048 + k * 1024); } while (0)
#define PG8_MMA(ai, bj, At, Bt) do { __builtin_amdgcn_s_setprio(1); _Pragma("unroll") for (int m = 0; m < 4; ++m) _Pragma("unroll") for (int n = 0; n < 2; ++n) _Pragma("unroll") for (int k = 0; k < 2; ++k) \
        acc[ai][bj][m][n] = __builtin_amdgcn_mfma_f32_16x16x32_bf16(Bt[n][k], At[m][k], acc[ai][bj][m][n], 0, 0, 0); __builtin_amdgcn_s_setprio(0); } while (0)
#define PG8_WAIT_V(n) asm volatile("s_waitcnt vmcnt(" #n ")" ::: "memory")
#define PG8_WAIT_L(n) asm volatile("s_waitcnt lgkmcnt(" #n ")" ::: "memory")
#define PG8_BAR __builtin_amdgcn_s_barrier()
#define PG8_SCHED __builtin_amdgcn_sched_barrier(0)
    Unit cur, nxt; int ui = 0;
    if (!S.next(0, cur)) return;
    f32x4 acc[2][2][4][2];
#pragma unroll
    for (int a = 0; a < 2; ++a)
#pragma unroll
        for (int b = 0; b < 2; ++b)
#pragma unroll
            for (int m = 0; m < 4; ++m)
#pragma unroll
                for (int n = 0; n < 2; ++n) acc[a][b][m][n] = (f32x4){0.f, 0.f, 0.f, 0.f};
    bf16x8 At[4][2], B0[2][2], B1[2][2];
    const char* cA = (const char*)g.A + (size_t)cur.pm * tstep; const char* cB = (const char*)g.Bt + (size_t)cur.pn * tstep;
    S.a_ready(cur);
    if constexpr (SP2) {
        PG8_STAGE(PG8_SB(0, 0), cB, voffB); PG8_STAGE(PG8_SB(0, 1), cB + hstep, voffB); PG8_STAGE(PG8_SA(0, 0), cA, voffA); PG8_STAGE(PG8_SA(0, 1), cA + hstep, voffA);
        if (wr == 1) PG8_BAR;
        PG8_WAIT_V(2); PG8_BAR;
        PG8_STAGE(PG8_SB(1, 0), cB + kstep, voffB); PG8_STAGE(PG8_SA(1, 0), cA + kstep, voffA); PG8_STAGE(PG8_SB(1, 1), cB + hstep + kstep, voffB);
        PG8_WAIT_V(6); PG8_BAR;
    } else {
        PG8_STAGE(PG8_SB(0, 0), cB, voffB); PG8_STAGE(PG8_SA(0, 0), cA, voffA); PG8_STAGE(PG8_SB(0, 1), cB + hstep, voffB); PG8_STAGE(PG8_SA(0, 1), cA + hstep, voffA);
        if (wr == 1) PG8_BAR;
        PG8_WAIT_V(4); PG8_BAR;
        PG8_STAGE(PG8_SB(1, 0), cB + kstep, voffB); PG8_STAGE(PG8_SA(1, 0), cA + kstep, voffA); PG8_STAGE(PG8_SB(1, 1), cB + hstep + kstep, voffB);
        PG8_WAIT_V(6); PG8_BAR;
    }
    for (;;) {
        const bool has_next = S.next(ui + 1, nxt);
        const char* nA = has_next ? (const char*)g.A + (size_t)nxt.pm * tstep : cA; const char* nB = has_next ? (const char*)g.Bt + (size_t)nxt.pn * tstep : cB;
        for (int t = 0; t < nt; t += 2) {
            const bool last = (t == nt - 2);
            const char* a1 = cA + (size_t)(t + 1) * kstep;
            const char* a2 = last ? nA : cA + (size_t)(t + 2) * kstep; const char* b2 = last ? nB : cB + (size_t)(t + 2) * kstep;
            const char* a3 = a2 + kstep; const char* b3 = b2 + kstep;
            if (last && has_next) S.a_ready(nxt);
            if constexpr (SP2) {
            PG8_LDB(B0, 0, 0); PG8_LDB(B1, 0, 1); PG8_SCHED; PG8_LDA(At, 0, 0); PG8_STAGE(PG8_SA(1, 1), a1 + hstep, voffA);
            PG8_WAIT_V(8); PG8_WAIT_L(0); PG8_BAR; PG8_MMA(0, 0, At, B0); PG8_MMA(0, 1, At, B1); PG8_BAR; PG8_SCHED;
            PG8_LDA(At, 0, 1); PG8_STAGE(PG8_SB(0, 0), b2, voffB); PG8_STAGE(PG8_SB(0, 1), b2 + hstep, voffB); PG8_STAGE(PG8_SA(0, 0), a2, voffA);
            PG8_WAIT_V(8); PG8_WAIT_L(0); PG8_BAR; PG8_MMA(1, 0, At, B0); PG8_MMA(1, 1, At, B1); PG8_BAR; PG8_SCHED;
            PG8_LDB(B0, 1, 0); PG8_LDB(B1, 1, 1); PG8_SCHED; PG8_LDA(At, 1, 0); PG8_STAGE(PG8_SA(0, 1), a2 + hstep, voffA);
            PG8_WAIT_V(8); PG8_WAIT_L(0); PG8_BAR; PG8_MMA(0, 0, At, B0); PG8_MMA(0, 1, At, B1); PG8_BAR; PG8_SCHED;
            PG8_LDA(At, 1, 1); PG8_STAGE(PG8_SB(1, 0), b3, voffB); PG8_STAGE(PG8_SB(1, 1), b3 + hstep, voffB); PG8_STAGE(PG8_SA(1, 0), a3, voffA);
            PG8_WAIT_V(8); PG8_WAIT_L(0); PG8_BAR; PG8_MMA(1, 0, At, B0); PG8_MMA(1, 1, At, B1); PG8_BAR; PG8_SCHED;
            } else {
            PG8_LDB(B0, 0, 0); PG8_SCHED; PG8_LDA(At, 0, 0); PG8_STAGE(PG8_SA(1, 1), a1 + hstep, voffA);
            PG8_WAIT_L(8); PG8_BAR; PG8_WAIT_L(0); PG8_MMA(0, 0, At, B0); PG8_BAR; PG8_SCHED;
            PG8_LDB(B1, 0, 1); PG8_STAGE(PG8_SB(0, 0), b2, voffB);
            PG8_BAR; PG8_WAIT_L(0); PG8_MMA(0, 1, At, B1); PG8_BAR;
            PG8_LDA(At, 0, 1); PG8_STAGE(PG8_SA(0, 0), a2, voffA);
            PG8_BAR; PG8_WAIT_L(0); PG8_MMA(1, 0, At, B0); PG8_BAR; PG8_SCHED;
            PG8_STAGE(PG8_SB(0, 1), b2 + hstep, voffB);
            PG8_WAIT_V(6); PG8_BAR; PG8_MMA(1, 1, At, B1); PG8_BAR;
            PG8_LDB(B0, 1, 0); PG8_SCHED; PG8_LDA(At, 1, 0); PG8_STAGE(PG8_SA(0, 1), a2 + hstep, voffA);
            PG8_WAIT_L(8); PG8_BAR; PG8_WAIT_L(0); PG8_MMA(0, 0, At, B0); PG8_BAR; PG8_SCHED;
            PG8_LDB(B1, 1, 1); PG8_STAGE(PG8_SB(1, 0), b3, voffB);
            PG8_BAR; PG8_WAIT_L(0); PG8_MMA(0, 1, At, B1); PG8_BAR;
            PG8_LDA(At, 1, 1); PG8_STAGE(PG8_SA(1, 0), a3, voffA);
            PG8_BAR; PG8_WAIT_L(0); PG8_MMA(1, 0, At, B0); PG8_BAR; PG8_SCHED;
            PG8_STAGE(PG8_SB(1, 1), b3 + hstep, voffB);
            PG8_WAIT_V(6); PG8_BAR; PG8_MMA(1, 1, At, B1); PG8_BAR;
            }
        }
        if constexpr (ALIGN_EPI) { if (wr == 0) PG8_BAR; }
        if constexpr (!Epi::AFTER_DRAIN) { E(acc, cur, wr, wc, fr, fq); S.done(cur); }
        if (!has_next) break;
#pragma unroll
        for (int a = 0; a < 2; ++a)
#pragma unroll
            for (int b = 0; b < 2; ++b)
#pragma unroll
                for (int m = 0; m < 4; ++m)
#pragma unroll
                    for (int n = 0; n < 2; ++n) acc[a][b][m][n] = (f32x4){0.f, 0.f, 0.f, 0.f};
        cur = nxt; cA = nA; cB = nB; ++ui;
        if constexpr (ALIGN_EPI) { if (wr == 1) PG8_BAR; }
    }
    PG8_WAIT_V(0);
    if constexpr (!ALIGN_EPI) { if (wr == 0) PG8_BAR; }
    PG8_BAR;
    if constexpr (Epi::AFTER_DRAIN) { E.fused(acc, cur, wr, wc, fr, fq, lds, wid, lane); S.done(cur); }
#undef PG8_SA
#undef PG8_SB
#undef PG8_STAGE
#undef PG8_LDA
#undef PG8_LDB
#undef PG8_MMA
#undef PG8_WAIT_V
#undef PG8_WAIT_L
#undef PG8_BAR
#undef PG8_SCHED
}
}
#define DI __device__ __forceinline__
#define LAS __attribute__((address_space(3)))
typedef unsigned short bf16;
typedef short bf16x8 __attribute__((ext_vector_type(8)));
typedef float f32x16 __attribute__((ext_vector_type(16)));
typedef float f32x4 __attribute__((ext_vector_type(4)));
typedef float f32x2 __attribute__((ext_vector_type(2)));
typedef unsigned u32x4 __attribute__((ext_vector_type(4)));
typedef unsigned u32x2 __attribute__((ext_vector_type(2)));
constexpr int NB = 4, S = 8192, T = NB * S, D = 1024, FF = 4096, HW = 2048  ;
constexpr int C_QLAT = 0, C_KVLAT = 256, C_KROPE = 512, C_NQ = 544, C_KC = 1056, C_VC = 1184, C_KS = 1312, C_VS = 1440, C_KW = 1568, C_VW = 1696, C_GATE = 1824, L0W = 1848;
constexpr float LN_EPS = 1e-5f, RMS_EPS = 1e-6f, ALPHA = 1.4142135623730951f, LOG2E = 1.4426950408889634f, NEGF = -1e30f;
constexpr float LAM_INIT = 0.35550906759096934f;
constexpr size_t MiB = 1u << 20;
constexpr size_t WS_WIN = 0, WS_WUQ = 4 * MiB, WS_WUKV = WS_WUQ + 768 * 256 * 2, WS_W1 = 5 * MiB, WS_WOUT = 6 * MiB, WS_WUP0 = 8 * MiB, WS_WDN0 = 16 * MiB, WS_WQKV = 24 * MiB, WS_WO = 30 * MiB, WS_WUP1 = 32 * MiB, WS_WDN1 = 40 * MiB;
constexpr size_t WS_STATS = 48 * MiB;
constexpr size_t WS_H = 50 * MiB;
constexpr size_t WS_XB = 178 * MiB;
constexpr size_t WS_QLN = 242 * MiB, WS_KVLN = 258 * MiB;
constexpr size_t WS_ACMP = 274 * MiB;
constexpr size_t WS_QRAW = 306 * MiB;
constexpr size_t WS_KV = 354 * MiB;
constexpr size_t WS_VTS = 418 * MiB, WS_VTW = 426 * MiB;
constexpr size_t WS_HID = 242 * MiB;
constexpr size_t WS_QKV = 242 * MiB;
constexpr size_t WS_VTD = 434 * MiB;
constexpr size_t WS_END = 498 * MiB;
constexpr size_t DO_OC = 0, DO_CH = 64 * MiB, DO_ROPE = 72 * MiB, DO_GATE = 73 * MiB, DO_KPE = 76 * MiB, DO_KC = 78 * MiB, DO_VCT = DO_KC + 512 * 1024, DO_SELM = 79 * MiB;
constexpr int LDS_BYTES = 147456;
constexpr size_t WS_CTL = 500 * MiB; constexpr int KN_WORD = 3584;

DI unsigned f2bf(float f) { unsigned u = __builtin_bit_cast(unsigned, f); return (u + 0x7fffu + ((u >> 16) & 1u)) >> 16; }
DI float bf2f(unsigned short h) { return __builtin_bit_cast(float, (unsigned)h << 16); }
DI unsigned pk2(float lo, float hi) { typedef __bf16 b2 __attribute__((ext_vector_type(2))); f32x2 v = {lo, hi}; b2 r = __builtin_convertvector(v, b2); return __builtin_bit_cast(unsigned, r); }
DI float wave_sum(float v) {
#pragma unroll
    for (int o = 1; o < 64; o <<= 1) v += __shfl_xor(v, o);
    return v; }
DI float xh_max(float v) { auto rr = __builtin_amdgcn_permlane32_swap(__float_as_uint(v), __float_as_uint(v), false, false); return fmaxf(__uint_as_float(rr[0]), __uint_as_float(rr[1])); }
DI float xh_sum(float v) { auto rr = __builtin_amdgcn_permlane32_swap(__float_as_uint(v), __float_as_uint(v), false, false); return __uint_as_float(rr[0]) + __uint_as_float(rr[1]); }

#define MFMA32(a, b, c) __builtin_amdgcn_mfma_f32_32x32x16_bf16((a), (b), (c), 0, 0, 0)
enum { M_CAUSAL = 0, M_WINDOW = 1, M_SEL = 2, M_CMP = 3 };
constexpr int STG = 28672;
DI int pi_row(int i) { const int j = i >> 4, w = i & 15; return 16 * j + 8 * ((w >> 2) & 1) + 4 * (w >> 3) + (w & 3); }
struct KVSrc { const bf16* K; int kp; const bf16* K2; const bf16* Vt; int vp; };
struct StageRegs { u32x4 k0, k1, v0, v1; };
template <int DQK, int DV> DI void stage_load(StageRegs& r, const KVSrc& s, int kb, int tid) {
    r.k0 = *(const u32x4*)(s.K + (size_t)(kb + (tid >> 3)) * s.kp + (tid & 7) * 8);
    if (DQK == 96) { if (tid < 256) r.k1 = *(const u32x4*)(s.K2 + (size_t)(kb + (tid >> 2)) * 32 + (tid & 3) * 8); }
    r.v0 = *(const u32x4*)(s.Vt + (size_t)(tid >> 3) * s.vp + kb + (tid & 7) * 8);
    if (DV == 128) r.v1 = *(const u32x4*)(s.Vt + (size_t)(64 + (tid >> 3)) * s.vp + kb + (tid & 7) * 8);
}
template <int DQK, int DV> DI void stage_store(const StageRegs& r, LAS char* buf, int tid) {
    constexpr int KSB = (DQK + 8) * 2, VOFF = 64 * KSB;
    *(LAS u32x4*)(buf + (tid >> 3) * KSB + (tid & 7) * 16) = r.k0;
    if (DQK == 96) { if (tid < 256) *(LAS u32x4*)(buf + (tid >> 2) * KSB + 128 + (tid & 3) * 16) = r.k1; }
    *(LAS u32x4*)(buf + VOFF + (tid >> 3) * 144 + (tid & 7) * 16) = r.v0;
    if (DV == 128) *(LAS u32x4*)(buf + VOFF + (64 + (tid >> 3)) * 144 + (tid & 7) * 16) = r.v1;
}
template <int DQK> DI void qk_tile(f32x16& s0, f32x16& s1, const LAS char* kbuf, const bf16x8 (&qf)[DQK / 16], int koff) {
    constexpr int KSB = (DQK + 8) * 2;
    bf16x8 a0[DQK / 16], a1[DQK / 16];
#pragma unroll
    for (int d0 = 0; d0 < DQK / 16; ++d0) { a0[d0] = *(const LAS bf16x8*)(kbuf + koff + d0 * 32); a1[d0] = *(const LAS bf16x8*)(kbuf + koff + 32 * KSB + d0 * 32); }
    __builtin_amdgcn_sched_barrier(0);
    f32x16 z;
#pragma unroll
    for (int r = 0; r < 16; ++r) z[r] = 0.f;
    s0 = MFMA32(a0[0], qf[0], z); s1 = MFMA32(a1[0], qf[0], z);
#pragma unroll
    for (int d0 = 1; d0 < DQK / 16; ++d0) { s0 = MFMA32(a0[d0], qf[d0], s0); s1 = MFMA32(a1[d0], qf[d0], s1); }
}
DI void v_load4(bf16x8 (&v)[4], const LAS char* vbuf, int voff, int blk) {
#pragma unroll
    for (int j = 0; j < 4; ++j) v[j] = *(const LAS bf16x8*)(vbuf + voff + blk * 32 * 144 + j * 32);
}
template <int MODE, bool ALIBI> DI void score_fix(f32x16& s0, f32x16& s1, float c2, float slope2, int dql, bool need_mask, bool lane_ok) {
    constexpr int KM = (MODE == M_CMP) ? 16 : 1;
    const float bl = ALIBI ? -slope2 * (float)dql : 0.f;
#pragma unroll
    for (int kh = 0; kh < 2; ++kh)
#pragma unroll
        for (int r = 0; r < 16; ++r) { const int kc = KM * (32 * kh + 16 * (r >> 3) + (r & 7));
            float v = kh ? s1[r] : s0[r];
            v = ALIBI ? __builtin_fmaf(v, c2, bl + slope2 * (float)kc) : v * c2;
            if (kh) s1[r] = v; else s0[r] = v; }
    if (need_mask) {
#pragma unroll
        for (int kh = 0; kh < 2; ++kh)
#pragma unroll
            for (int r = 0; r < 16; ++r) { const int kc = KM * (32 * kh + 16 * (r >> 3) + (r & 7));
                bool ok = kc <= dql; if (MODE == M_WINDOW) ok = ok && (kc > dql - 512);
                if (kh) s1[r] = ok ? s1[r] : NEGF; else s0[r] = ok ? s0[r] : NEGF; }
    }
    if (MODE == M_SEL) { if (!lane_ok) {
#pragma unroll
        for (int r = 0; r < 16; ++r) { s0[r] = NEGF; s1[r] = NEGF; } } }
}
DI float mx3(float a, float b, float c) { return __builtin_fmaxf(__builtin_fmaxf(a, b), c); }
DI float tile_max(const f32x16& s0, const f32x16& s1) {
    float a = mx3(s0[0], s0[1], s1[0]), b = mx3(s0[2], s0[3], s1[1]); a = mx3(a, s1[2], s1[3]);
#pragma unroll
    for (int r = 4; r < 16; r += 4) { a = mx3(a, s0[r], s0[r + 1]); b = mx3(b, s0[r + 2], s0[r + 3]); a = mx3(a, s1[r], s1[r + 1]); b = mx3(b, s1[r + 2], s1[r + 3]); }
    return xh_max(fmaxf(a, b)); }
DI void pack_p(bf16x8 (&pf)[4], const f32x16& s0, const f32x16& s1) {
#pragma unroll
    for (int j = 0; j < 2; ++j) { u32x4 w0, w1;
        w0.x = pk2(s0[8 * j], s0[8 * j + 1]); w0.y = pk2(s0[8 * j + 2], s0[8 * j + 3]); w0.z = pk2(s0[8 * j + 4], s0[8 * j + 5]); w0.w = pk2(s0[8 * j + 6], s0[8 * j + 7]);
        w1.x = pk2(s1[8 * j], s1[8 * j + 1]); w1.y = pk2(s1[8 * j + 2], s1[8 * j + 3]); w1.z = pk2(s1[8 * j + 4], s1[8 * j + 5]); w1.w = pk2(s1[8 * j + 6], s1[8 * j + 7]);
        pf[j] = __builtin_bit_cast(bf16x8, w0); pf[2 + j] = __builtin_bit_cast(bf16x8, w1); }
}
template <int DV> DI void pv_tile(f32x16 (&o)[DV / 32], const LAS char* vbuf, const bf16x8 (&pf)[4], int voff, const bf16x8 (&v0)[4]) {
    if (DV == 64) {
        bf16x8 vn[4]; v_load4(vn, vbuf, voff, 1);
        __builtin_amdgcn_sched_barrier(0);
#pragma unroll
        for (int j = 0; j < 4; ++j) o[0] = MFMA32(v0[j], pf[j], o[0]);
#pragma unroll
        for (int j = 0; j < 4; ++j) o[1] = MFMA32(vn[j], pf[j], o[1]);
    } else {
#pragma unroll
        for (int blk = 0; blk < DV / 32; ++blk) {
            bf16x8 vc[4]; v_load4(vc, vbuf, voff, blk);
            __builtin_amdgcn_sched_barrier(0);
#pragma unroll
            for (int j = 0; j < 4; ++j) o[blk] = MFMA32(vc[j], pf[j], o[blk]);
        }
    }
}
template <int MODE> DI int next_tile(int t, int t0, unsigned u0, unsigned u1, unsigned u2, unsigned u3) {
    --t;
    if (MODE == M_SEL) { while (t >= t0) { const unsigned w = (t < 32) ? u0 : (t < 64) ? u1 : (t < 96) ? u2 : u3; if ((w >> (t & 31)) & 1u) break; --t; } }
    return t >= t0 ? t : -1;
}
template <int DQK, bool ALIBI> DI void qk_tile2(f32x16& s0, f32x16& s1, const LAS char* kbuf, const bf16x8 (&qf)[DQK / 16], int koff, bf16x8 qx, bf16x8 kx0) {
    constexpr int KSB = (DQK + 8) * 2, NH = DQK / 32;
    bf16x8 a0[NH], a1[NH];
#pragma unroll
    for (int d0 = 0; d0 < NH; ++d0) { a0[d0] = *(const LAS bf16x8*)(kbuf + koff + d0 * 32); a1[d0] = *(const LAS bf16x8*)(kbuf + koff + 32 * KSB + d0 * 32); }
    __builtin_amdgcn_sched_barrier(0);
    f32x16 z;
#pragma unroll
    for (int r = 0; r < 16; ++r) z[r] = 0.f;
    if (ALIBI) { s0 = MFMA32(kx0, qx, z); s1 = MFMA32(kx0, qx, z); s0 = MFMA32(a0[0], qf[0], s0); s1 = MFMA32(a1[0], qf[0], s1); }
    else { s0 = MFMA32(a0[0], qf[0], z); s1 = MFMA32(a1[0], qf[0], z); }
    bf16x8 b0[DQK / 16 - NH], b1[DQK / 16 - NH];
#pragma unroll
    for (int d0 = NH; d0 < DQK / 16; ++d0) { b0[d0 - NH] = *(const LAS bf16x8*)(kbuf + koff + d0 * 32); b1[d0 - NH] = *(const LAS bf16x8*)(kbuf + koff + 32 * KSB + d0 * 32); }
    __builtin_amdgcn_sched_barrier(0);
#pragma unroll
    for (int d0 = 1; d0 < NH; ++d0) { s0 = MFMA32(a0[d0], qf[d0], s0); s1 = MFMA32(a1[d0], qf[d0], s1); }
#pragma unroll
    for (int d0 = NH; d0 < DQK / 16; ++d0) { s0 = MFMA32(b0[d0 - NH], qf[d0], s0); s1 = MFMA32(b1[d0 - NH], qf[d0], s1); }
}
template <int DQK, int DV, int MODE, bool ALIBI>
DI bool tile_compute(f32x16 (&o)[DV / 32], float& m, float& l, const bf16x8 (&qf)[DQK / 16], bf16x8 qx, bf16x8 kx0, const LAS char* buf, int t, int qpos, int q0w, u32x4 sel,
                     float c2, float slope2, float qbound, int koff, int voff) {
    const int kbase = 64 * t;
    bool lane_ok = true; if (MODE == M_SEL) { const unsigned w = (t < 32) ? sel.x : (t < 64) ? sel.y : (t < 96) ? sel.z : sel.w; lane_ok = (w >> (t & 31)) & 1u; }
    bool skip = (kbase > q0w + 31); if (MODE == M_WINDOW) skip = skip || (kbase + 63 < q0w - 511);
    if (MODE == M_SEL) skip = skip || !__any(lane_ok);
    bool dead = false;
    if (ALIBI) { const int dmin = qpos - kbase - 63; const float ub = qbound - slope2 * (float)(dmin > 0 ? dmin : 0); dead = __all(ub < m - 40.f); skip = skip || dead; }
    if (!skip) {
        f32x16 s0, s1; qk_tile2<DQK, ALIBI>(s0, s1, buf, qf, koff, qx, kx0);
        bf16x8 v0[4]; if (DV == 64) { v_load4(v0, buf, voff, 0); __builtin_amdgcn_sched_barrier(0); }
        bool need_mask = kbase + 63 > q0w; if (MODE == M_WINDOW) need_mask = need_mask || (q0w + 31 - kbase >= 512);
        const int dq = qpos - kbase;
        const float tb = (ALIBI ? -slope2 * (float)dq : 0.f) - m, tb1 = ALIBI ? tb + 32.f * slope2 : tb;
#pragma unroll
        for (int r = 0; r < 16; ++r) { s0[r] = __builtin_fmaf(s0[r], c2, tb); s1[r] = __builtin_fmaf(s1[r], c2, tb1); }
        if (need_mask || MODE == M_SEL) {
            const int dqh = lane_ok ? dq - 8 * (int)((threadIdx.x >> 5) & 1) : -1000000;
#pragma unroll
            for (int kh = 0; kh < 2; ++kh)
#pragma unroll
                for (int r = 0; r < 16; ++r) { const int kc = 32 * kh + 16 * (r >> 3) + (r & 7);
                    bool ok = (kc <= dqh); if (MODE == M_WINDOW) ok = ok && (kc > dqh - 512);
                    if (kh) s1[r] = ok ? s1[r] : NEGF; else s0[r] = ok ? s0[r] : NEGF; }
        }
        const float mx = tile_max(s0, s1);
        if (__any(mx > 6.f)) { const float dl = fmaxf(mx, 0.f), f = __builtin_amdgcn_exp2f(-dl); m += dl; l *= f;
#pragma unroll
            for (int r = 0; r < 16; ++r) { s0[r] -= dl; s1[r] -= dl; }
#pragma unroll
            for (int blk = 0; blk < DV / 32; ++blk) o[blk] *= f; }
        float sum = 0.f;
#pragma unroll
        for (int r = 0; r < 16; ++r) { s0[r] = __builtin_amdgcn_exp2f(s0[r]); s1[r] = __builtin_amdgcn_exp2f(s1[r]); sum += s0[r] + s1[r]; }
        l += sum;
        bf16x8 pf[4]; pack_p(pf, s0, s1);
        pv_tile<DV>(o, buf, pf, voff, v0);
    }
    return dead;
}
template <int DQK, int DV, int MODE, bool ALIBI>
DI void run_tiles(f32x16 (&o)[DV / 32], float& m, float& l, const bf16x8 (&qf)[DQK / 16], const KVSrc& src, int t0, int t1, unsigned u0, unsigned u1, unsigned u2, unsigned u3,
                  int qpos, int q0w, u32x4 sel, float c2, float slope2, float knmax, LAS char* lds, int tid, int lane) {
    constexpr int KSB = (DQK + 8) * 2, VOFF = 64 * KSB;
    const int l31 = lane & 31, hi = lane >> 5;
    const int koff = pi_row(l31) * KSB + hi * 16, voff = VOFF + l31 * 144 + hi * 16;
    bf16x8 qx, kx0; float qbound = 0.f;
#pragma unroll
    for (int e = 0; e < 8; ++e) { qx[e] = 0; kx0[e] = 0; }
    if (ALIBI) {
        const float sq = slope2 / c2; const unsigned sh = f2bf(sq); const float rem = sq - __builtin_bit_cast(float, sh << 16); const unsigned slo = f2bf(rem);
        if (hi == 0) { qx[0] = (short)sh; qx[1] = (short)slo; const short a = (short)f2bf((float)pi_row(l31)); kx0[0] = a; kx0[1] = a; }
        float ss = 0.f;
#pragma unroll
        for (int d0 = 0; d0 < DQK / 16; ++d0)
#pragma unroll
            for (int e = 0; e < 8; ++e) { const float x = bf2f((unsigned short)qf[d0][e]); ss += x * x; }
        qbound = sqrtf(xh_sum(ss)) * knmax * c2 * 1.001f + 0.01f;
    }
    { const bf16* kd = src.K + (size_t)qpos * src.kp + 8 * hi; float dot = 0.f;
#pragma unroll
      for (int d0 = 0; d0 < DQK / 16; ++d0) { const bf16x8 kk = (DQK == 96 && d0 >= 4) ? *(const bf16x8*)(src.K2 + (size_t)qpos * 32 + (d0 - 4) * 16 + 8 * hi) : *(const bf16x8*)(kd + d0 * 16);
#pragma unroll
          for (int e = 0; e < 8; ++e) dot += bf2f((unsigned short)kk[e]) * bf2f((unsigned short)qf[d0][e]); }
      m = xh_sum(dot) * c2; }
    StageRegs sr; int t = t1, cur = 0;
    LAS int* dslot = (LAS int*)(lds + 2 * STG + 256);
    const int wid_ = tid >> 6; bool counted = false;
    if (ALIBI) { if (lane == 0) dslot[wid_] = -1; }
    stage_load<DQK, DV>(sr, src, 64 * t, tid); stage_store<DQK, DV>(sr, lds, tid); __syncthreads();
    while (t >= 0) {
        const int tn = next_tile<MODE>(t, t0, u0, u1, u2, u3);
        if (tn >= 0) stage_load<DQK, DV>(sr, src, 64 * tn, tid);
        const bool dead = tile_compute<DQK, DV, MODE, ALIBI>(o, m, l, qf, qx, kx0, lds + cur * STG, t, qpos, q0w, sel, c2, slope2, qbound, koff, voff);
        if (ALIBI) { if (dead && !counted) { if (lane == 0) dslot[wid_] = t; counted = true; } }
        if (tn >= 0) stage_store<DQK, DV>(sr, lds + (cur ^ 1) * STG, tid);
        __syncthreads();
        if (ALIBI) { const u32x4 d0 = *(const LAS u32x4*)dslot, d1 = *(const LAS u32x4*)(dslot + 4);
            const bool all = (int)d0.x >= t && (int)d0.y >= t && (int)d0.z >= t && (int)d0.w >= t && (int)d1.x >= t && (int)d1.y >= t && (int)d1.z >= t && (int)d1.w >= t;
            if (__builtin_amdgcn_readfirstlane((int)all)) break; }
        cur ^= 1; t = tn;
    }
    __syncthreads();
}
template <int DQK, int DV>
DI void run_tiles2(f32x16 (&o)[DV / 32], float& m, float& l, const bf16x8 (&qf)[DQK / 16], const KVSrc& src, int t1, int qpos, int q0w, float c2, LAS char* lds, int tid, int lane) {
    constexpr int KSB = (DQK + 8) * 2, VOFF = 64 * KSB;
    const int l31 = lane & 31, hi = lane >> 5;
    const int koff = pi_row(l31) * KSB + hi * 16, voff = VOFF + l31 * 144 + hi * 16;
    { const bf16* kd = src.K + (size_t)qpos * src.kp + 8 * hi; float dot = 0.f;
#pragma unroll
      for (int d0 = 0; d0 < DQK / 16; ++d0) { const bf16x8 kk = (DQK == 96 && d0 >= 4) ? *(const bf16x8*)(src.K2 + (size_t)qpos * 32 + (d0 - 4) * 16 + 8 * hi) : *(const bf16x8*)(kd + d0 * 16);
#pragma unroll
          for (int e = 0; e < 8; ++e) dot += bf2f((unsigned short)kk[e]) * bf2f((unsigned short)qf[d0][e]); }
      m = xh_sum(dot) * c2; }
    bf16x8 qx;
#pragma unroll
    for (int e = 0; e < 8; ++e) qx[e] = 0;
    StageRegs ra, rb; int ta = t1, cur = 0;
    stage_load<DQK, DV>(ra, src, 64 * ta, tid); stage_load<DQK, DV>(rb, src, 64 * (ta - 1), tid);
    stage_store<DQK, DV>(ra, lds, tid); stage_store<DQK, DV>(rb, lds + STG, tid); __syncthreads();
    while (ta >= 0) {
        const int tn = ta - 2;
        if (tn >= 0) { stage_load<DQK, DV>(ra, src, 64 * tn, tid); stage_load<DQK, DV>(rb, src, 64 * (tn - 1), tid); }
        const LAS char* bufa = lds + (2 * cur) * STG; const LAS char* bufb = bufa + STG;
        const int kba = 64 * ta, kbb = kba - 64;
        if (!(kbb > q0w + 31)) {
            f32x16 a0, a1, b0, b1;
            { f32x16 z;
#pragma unroll
              for (int r = 0; r < 16; ++r) z[r] = 0.f;
              a0 = z; a1 = z; b0 = z; b1 = z;
              bf16x8 fa0 = *(const LAS bf16x8*)(bufa + koff), fa1 = *(const LAS bf16x8*)(bufa + koff + 32 * KSB), fb0 = *(const LAS bf16x8*)(bufb + koff), fb1 = *(const LAS bf16x8*)(bufb + koff + 32 * KSB);
#pragma unroll
              for (int d0 = 0; d0 < DQK / 16; ++d0) {
                  bf16x8 na0 = fa0, na1 = fa1, nb0 = fb0, nb1 = fb1;
                  if (d0 + 1 < DQK / 16) { na0 = *(const LAS bf16x8*)(bufa + koff + (d0 + 1) * 32); na1 = *(const LAS bf16x8*)(bufa + koff + 32 * KSB + (d0 + 1) * 32); nb0 = *(const LAS bf16x8*)(bufb + koff + (d0 + 1) * 32); nb1 = *(const LAS bf16x8*)(bufb + koff + 32 * KSB + (d0 + 1) * 32); }
                  __builtin_amdgcn_sched_barrier(0);
                  a0 = MFMA32(fa0, qf[d0], a0); a1 = MFMA32(fa1, qf[d0], a1); b0 = MFMA32(fb0, qf[d0], b0); b1 = MFMA32(fb1, qf[d0], b1);
                  fa0 = na0; fa1 = na1; fb0 = nb0; fb1 = nb1; } }
            const float tb = -m;
#pragma unroll
            for (int r = 0; r < 16; ++r) { a0[r] = __builtin_fmaf(a0[r], c2, tb); a1[r] = __builtin_fmaf(a1[r], c2, tb); b0[r] = __builtin_fmaf(b0[r], c2, tb); b1[r] = __builtin_fmaf(b1[r], c2, tb); }
            if (kba + 63 > q0w) { const int dqa = qpos - kba - 8 * hi, dqb = dqa + 64;
#pragma unroll
                for (int kh = 0; kh < 2; ++kh)
#pragma unroll
                    for (int r = 0; r < 16; ++r) { const int kc = 32 * kh + 16 * (r >> 3) + (r & 7); const bool oka = (kc <= dqa), okb = (kc <= dqb);
                        if (kh) { a1[r] = oka ? a1[r] : NEGF; b1[r] = okb ? b1[r] : NEGF; } else { a0[r] = oka ? a0[r] : NEGF; b0[r] = okb ? b0[r] : NEGF; } } }
            const float mx = fmaxf(tile_max(a0, a1), tile_max(b0, b1));
            if (__any(mx > 6.f)) { const float dl = fmaxf(mx, 0.f), f = __builtin_amdgcn_exp2f(-dl); m += dl; l *= f;
#pragma unroll
                for (int r = 0; r < 16; ++r) { a0[r] -= dl; a1[r] -= dl; b0[r] -= dl; b1[r] -= dl; }
#pragma unroll
                for (int blk = 0; blk < DV / 32; ++blk) o[blk] *= f; }
            float sum = 0.f;
#pragma unroll
            for (int r = 0; r < 16; ++r) { a0[r] = __builtin_amdgcn_exp2f(a0[r]); a1[r] = __builtin_amdgcn_exp2f(a1[r]); b0[r] = __builtin_amdgcn_exp2f(b0[r]); b1[r] = __builtin_amdgcn_exp2f(b1[r]); sum += (a0[r] + a1[r]) + (b0[r] + b1[r]); }
            l += sum;
            bf16x8 pa[4], pb[4]; pack_p(pa, a0, a1); pack_p(pb, b0, b1);
#pragma unroll
            for (int blk = 0; blk < DV / 32; ++blk) {
                { bf16x8 vc[4]; v_load4(vc, bufa, voff, blk); __builtin_amdgcn_sched_barrier(0);
#pragma unroll
                  for (int j = 0; j < 4; ++j) o[blk] = MFMA32(vc[j], pa[j], o[blk]); }
                { bf16x8 vc[4]; v_load4(vc, bufb, voff, blk); __builtin_amdgcn_sched_barrier(0);
#pragma unroll
                  for (int j = 0; j < 4; ++j) o[blk] = MFMA32(vc[j], pb[j], o[blk]); }
            }
        }
        if (tn >= 0) { stage_store<DQK, DV>(ra, lds + (2 * (cur ^ 1)) * STG, tid); stage_store<DQK, DV>(rb, lds + (2 * (cur ^ 1) + 1) * STG, tid); }
        __syncthreads();
        cur ^= 1; ta = tn;
    }
}
template <int DQK> DI void load_q(bf16x8 (&qf)[DQK / 16], const bf16* Qrow, int hi) {
#pragma unroll
    for (int d0 = 0; d0 < DQK / 16; ++d0) qf[d0] = *(const bf16x8*)(Qrow + d0 * 16 + hi * 8);
}
template <int DV> DI void store_o_bf16(const f32x16 (&o)[DV / 32], float inv, bf16* dst, int hi) {
#pragma unroll
    for (int blk = 0; blk < DV / 32; ++blk)
#pragma unroll
        for (int rr = 0; rr < 4; ++rr) { u32x2 w; w.x = pk2(o[blk][4 * rr] * inv, o[blk][4 * rr + 1] * inv); w.y = pk2(o[blk][4 * rr + 2] * inv, o[blk][4 * rr + 3] * inv);
            *(u32x2*)(dst + 32 * blk + 8 * rr + 4 * hi) = w; }
}
#define RLX_AGENT __ATOMIC_RELAXED, __HIP_MEMORY_SCOPE_AGENT
#define XB_TMO      128
#define XB_XCNT(j)  (256  + 64 * (j))
#define XB_XSUB(j)  (1280 + 64 * (j))
#define XB_XGEN(j)  (2304 + 64 * (j))
#define XB_TOP      3328
#define XB_TOPGEN   3392
#define XCD_BAR_WORDS 3456
#define XB_SPIN_CAP (1u << 18)

__device__ __forceinline__ unsigned xb_ld(unsigned* p)              { return __hip_atomic_load(p, __ATOMIC_RELAXED, __HIP_MEMORY_SCOPE_AGENT); }
__device__ __forceinline__ unsigned xb_add(unsigned* p, unsigned v) { return __hip_atomic_fetch_add(p, v, __ATOMIC_RELAXED, __HIP_MEMORY_SCOPE_AGENT); }
__device__ __forceinline__ unsigned xb_xcc_id() { return (unsigned)__builtin_amdgcn_s_getreg((3 << 11) | 20) & 0xFu; }
#define XB_SPIN(cond, bar) do { unsigned _sp = 0; while (cond) { __builtin_amdgcn_s_sleep(1); \
    if ((++_sp & 255u) == 0u) { if (xb_ld(&(bar)[XB_TMO])) break; if (_sp > XB_SPIN_CAP) { atomicAdd(&(bar)[XB_TMO], 1u); break; } } } } while (0)

struct XcdBarrier {
    unsigned* bar; unsigned x;
    volatile LAS unsigned* st;
};

__device__ __forceinline__ XcdBarrier xcd_barrier_post(unsigned* bar, volatile LAS unsigned* st) {
    XcdBarrier b; b.bar = bar; b.x = xb_xcc_id(); b.st = st;
    if (threadIdx.x == 0) (void)xb_add(&bar[XB_XCNT(b.x)], 1u);
    return b;
}
__device__ __forceinline__ void xcd_barrier_complete(unsigned* bar, unsigned x, unsigned& nloc, unsigned& nx) {
    const unsigned G = gridDim.x * gridDim.y * gridDim.z;
    unsigned sum, cnt, mine, sp = 0u;
    for (;;) {
        sum = 0u; cnt = 0u; mine = 0u;
#pragma unroll
        for (unsigned j = 0; j < 16; ++j) { const unsigned c = xb_ld(&bar[XB_XCNT(j)]); sum += c; cnt += (c > 0u) ? 1u : 0u; mine = (j == x) ? c : mine; }
        if (sum == G) break;
        __builtin_amdgcn_s_sleep(1);
        if ((++sp & 255u) == 0u) { if (xb_ld(&bar[XB_TMO])) break; if (sp > XB_SPIN_CAP) { atomicAdd(&bar[XB_TMO], 1u); break; } }
    }
    nloc = mine > 0u ? mine : 1u; nx = cnt > 0u ? cnt : 1u;
}

__device__ __forceinline__ void xcd_barrier(const XcdBarrier& b) {
    asm volatile("s_waitcnt vmcnt(0)" ::: "memory");
    __syncthreads();
    if (threadIdx.x == 0) {
        unsigned* bar = b.bar;
        __builtin_amdgcn_s_waitcnt(0);
        unsigned nloc = b.st[0], nx = b.st[1];
        if (nloc == 0u) { xcd_barrier_complete(bar, b.x, nloc, nx); b.st[0] = nloc; b.st[1] = nx; }
        const unsigned old = xb_add(&bar[XB_XSUB(b.x)], 1u);
        const unsigned gen = old / nloc;
        if (old + 1u == (gen + 1u) * nloc) {
            __builtin_amdgcn_fence(__ATOMIC_RELEASE, "agent");
            asm volatile("s_waitcnt vmcnt(0)" ::: "memory");
            const unsigned og = xb_add(&bar[XB_TOP], 1u);
            const unsigned tg = og / nx;
            if (og + 1u == (tg + 1u) * nx) xb_add(&bar[XB_TOPGEN], 1u);
            else XB_SPIN(xb_ld(&bar[XB_TOPGEN]) == tg, bar);
            __builtin_amdgcn_fence(__ATOMIC_ACQUIRE, "agent");
            xb_add(&bar[XB_XGEN(b.x)], 1u);
            asm volatile("s_waitcnt vmcnt(0)" ::: "memory");
        } else {
            XB_SPIN(xb_ld(&bar[XB_XGEN(b.x)]) == gen, bar);
            __builtin_amdgcn_fence(__ATOMIC_ACQUIRE, "agent");
            asm volatile("s_waitcnt vmcnt(0)" ::: "memory");
        }
    }
    __syncthreads();
}
struct Ptrs {
    const float* in[32]; float* out; unsigned char* ws; unsigned char* dob;
};
DI int vcu_of(int bid, int G) { return (G % 8 == 0) ? (bid % 8) * (G / 8) + bid / 8 : bid; }

DI void mla_unit(const Ptrs& P, int b, int h, int qb, LAS char* lds, int tid, int lane, int wid) {
    asm volatile("" : "+v"(tid), "+v"(lane));
    const int l31 = lane & 31, hi = lane >> 5, q0 = qb * 256, q0w = q0 + 32 * wid, qpos = q0w + l31;
    const bf16* Qrow = (const bf16*)(P.ws + WS_QRAW) + (size_t)(b * S + qpos) * 768 + h * 96;
    bf16x8 qf[6]; load_q<96>(qf, Qrow, hi);
    { const f32x2* rp = (const f32x2*)(P.dob + DO_ROPE) + (size_t)qpos * 16 + 8 * hi; u32x4 a = __builtin_bit_cast(u32x4, qf[4]), c = __builtin_bit_cast(u32x4, qf[5]); unsigned ra[4], rc[4];
#pragma unroll
      for (int e = 0; e < 4; ++e) { const unsigned wa = a[e], wc = c[e]; const f32x2 cs0 = rp[2 * e], cs1 = rp[2 * e + 1];
          const float x1a = bf2f((unsigned short)(wa & 0xffffu)), x1b = bf2f((unsigned short)(wa >> 16)), x2a = bf2f((unsigned short)(wc & 0xffffu)), x2b = bf2f((unsigned short)(wc >> 16));
          ra[e] = pk2(x1a * cs0.x - x2a * cs0.y, x1b * cs1.x - x2b * cs1.y); rc[e] = pk2(x1a * cs0.y + x2a * cs0.x, x1b * cs1.y + x2b * cs1.x); }
      qf[4] = __builtin_bit_cast(bf16x8, (u32x4){ra[0], ra[1], ra[2], ra[3]}); qf[5] = __builtin_bit_cast(bf16x8, (u32x4){rc[0], rc[1], rc[2], rc[3]}); }
    KVSrc src; src.K = (const bf16*)(P.ws + WS_KV) + (size_t)(b * S) * 1024 + h * 128; src.kp = 1024; src.K2 = (const bf16*)(P.dob + DO_KPE) + (size_t)(b * S) * 32;
    src.Vt = (const bf16*)(P.ws + WS_QLN) + (size_t)((b * 8 + h) * 64) * S; src.vp = S;
    f32x16 o[2];
#pragma unroll
    for (int r = 0; r < 16; ++r) { o[0][r] = 0.f; o[1][r] = 0.f; }
    float m = NEGF, l = 0.f;
    run_tiles2<96, 64>(o, m, l, qf, src, (q0 + 255) >> 6, qpos, q0w, 0.10206207261596577f * LOG2E, lds, tid, lane);
    const float inv = 1.f / xh_sum(l);
    store_o_bf16<64>(o, inv, (bf16*)(P.ws + WS_XB) + (size_t)(b * S + qpos) * 1024 + h * 64, hi);
}
DI void diff_unit(const Ptrs& P, int b, int h, int j, int qb, LAS char* lds, int tid, int lane, int wid) {
    asm volatile("" : "+v"(tid), "+v"(lane));
    const int l31 = lane & 31, hi = lane >> 5, q0 = qb * 256, q0w = q0 + 32 * wid, qpos = q0w + l31;
    const bf16* QKV = (const bf16*)(P.ws + WS_QKV);
    bf16x8 qf[4]; load_q<64>(qf, QKV + (size_t)(b * S + qpos) * 3072 + h * 128 + j * 64, hi);
    KVSrc src; src.K = QKV + (size_t)(b * S) * 3072 + 1024 + h * 128 + j * 64; src.kp = 3072; src.K2 = nullptr;
    src.Vt = (const bf16*)(P.ws + WS_VTD) + (size_t)((b * 8 + h) * 128) * S; src.vp = S;
    f32x16 o[4];
#pragma unroll
    for (int r = 0; r < 16; ++r) { o[0][r] = 0.f; o[1][r] = 0.f; o[2][r] = 0.f; o[3][r] = 0.f; }
    float m = NEGF, l = 0.f;
    const float slope2 = __builtin_amdgcn_exp2f(-(float)(h + 1)) * LOG2E;
    const float knmax = sqrtf(__builtin_bit_cast(float, ((const unsigned*)(P.ws + WS_CTL))[KN_WORD + (b * 8 + h) * 2 + j]));
    run_tiles<64, 128, M_CAUSAL, true>(o, m, l, qf, src, 0, (q0 + 255) >> 6, 0u, 0u, 0u, 0u, qpos, q0w, (u32x4){0u, 0u, 0u, 0u}, 0.125f * LOG2E, slope2, knmax, lds, tid, lane);
    const float inv = 1.f / xh_sum(l);
    store_o_bf16<128>(o, inv, (bf16*)P.dob + (size_t)(b * S + qpos) * 2048 + h * 256 + j * 128, hi);
}
DI void nsa_sw_unit(const Ptrs& P, int b, int h, int qb, LAS char* lds, int tid, int lane, int wid) {
    asm volatile("" : "+v"(tid), "+v"(lane));
    const int l31 = lane & 31, hi = lane >> 5, q0 = qb * 256, q0w = q0 + 32 * wid, qpos = q0w + l31, g = h >> 2;
    const bf16* Hb = (const bf16*)(P.ws + WS_H);
    bf16x8 qf[4]; load_q<64>(qf, Hb + (size_t)(b * S + qpos) * HW + C_NQ + h * 64, hi);
    const float slope2 = __builtin_amdgcn_exp2f(-(float)(h + 1)) * LOG2E, c2 = 0.125f * LOG2E;
    f32x16 ow[2], os[2];
#pragma unroll
    for (int r = 0; r < 16; ++r) { ow[0][r] = 0.f; ow[1][r] = 0.f; os[0][r] = 0.f; os[1][r] = 0.f; }
    { KVSrc src; src.K = Hb + (size_t)(b * S) * HW + C_KW + g * 64; src.kp = HW; src.K2 = nullptr; src.Vt = (const bf16*)(P.ws + WS_VTW) + (size_t)((b * 2 + g) * 64) * S; src.vp = S;
      float m = NEGF, l = 0.f; int t0 = (q0 - 511) >> 6; if (t0 < 0) t0 = 0;
      run_tiles<64, 64, M_WINDOW, true>(ow, m, l, qf, src, t0, (q0 + 255) >> 6, 0u, 0u, 0u, 0u, qpos, q0w, (u32x4){0u, 0u, 0u, 0u}, c2, slope2, sqrtf(__builtin_bit_cast(float, ((const unsigned*)(P.ws + WS_CTL))[KN_WORD + 64 + 8 + b * 2 + g])), lds, tid, lane);
      const float inv = 1.f / xh_sum(l); ow[0] *= inv; ow[1] *= inv; }
    const u32x4 sel = *(const u32x4*)((const unsigned*)(P.dob + DO_SELM) + (size_t)((b * 2 + g) * S + qpos) * 4);
    unsigned u0 = sel.x, u1 = sel.y, u2 = sel.z, u3 = sel.w;
#pragma unroll
    for (int o = 1; o < 64; o <<= 1) { u0 |= __shfl_xor(u0, o); u1 |= __shfl_xor(u1, o); u2 |= __shfl_xor(u2, o); u3 |= __shfl_xor(u3, o); }
    LAS unsigned* ex = (LAS unsigned*)(lds + 2 * STG);
    if (lane == 0) { ex[wid * 4] = u0; ex[wid * 4 + 1] = u1; ex[wid * 4 + 2] = u2; ex[wid * 4 + 3] = u3; }
    __syncthreads();
    u0 = u1 = u2 = u3 = 0u;
#pragma unroll
    for (int w = 0; w < 8; ++w) { u0 |= ex[w * 4]; u1 |= ex[w * 4 + 1]; u2 |= ex[w * 4 + 2]; u3 |= ex[w * 4 + 3]; }
    u0 = __builtin_amdgcn_readfirstlane(u0) | 1u; u1 = __builtin_amdgcn_readfirstlane(u1); u2 = __builtin_amdgcn_readfirstlane(u2); u3 = __builtin_amdgcn_readfirstlane(u3);
    { KVSrc src; src.K = Hb + (size_t)(b * S) * HW + C_KS + g * 64; src.kp = HW; src.K2 = nullptr; src.Vt = (const bf16*)(P.ws + WS_VTS) + (size_t)((b * 2 + g) * 64) * S; src.vp = S;
      float m = NEGF, l = 0.f;
      run_tiles<64, 64, M_SEL, true>(os, m, l, qf, src, 0, (q0 + 255) >> 6, u0, u1, u2, u3, qpos, q0w, sel, c2, slope2, sqrtf(__builtin_bit_cast(float, ((const unsigned*)(P.ws + WS_CTL))[KN_WORD + 64 + b * 2 + g])), lds, tid, lane);
      const float inv = 1.f / xh_sum(l); os[0] *= inv; os[1] *= inv; }
    const size_t row = (size_t)(b * S + qpos);
    const float* gp = (const float*)(P.dob + DO_GATE) + row * 24 + h * 3; const float g0 = gp[0], g1 = gp[1], g2 = gp[2];
    const float* oc = (const float*)(P.dob + DO_OC) + row * 512 + h * 64; bf16* dst = (bf16*)(P.ws + WS_XB) + row * 1024 + 512 + h * 64;
#pragma unroll
    for (int blk = 0; blk < 2; ++blk)
#pragma unroll
        for (int rr = 0; rr < 4; ++rr) { const int d = 32 * blk + 8 * rr + 4 * hi; const f32x4 c = *(const f32x4*)(oc + d); float v[4];
#pragma unroll
            for (int e = 0; e < 4; ++e) v[e] = g0 * c[e] + g1 * os[blk][4 * rr + e] + g2 * ow[blk][4 * rr + e];
            u32x2 w; w.x = pk2(v[0], v[1]); w.y = pk2(v[2], v[3]); *(u32x2*)(dst + d) = w; }
}
constexpr int CSTG = 18432, C_PROW = 2 * CSTG, C_IMPH = C_PROW + 8 * 32 * 272;
DI void stage_load_k64(StageRegs& r, const KVSrc& s, int kb, int tid) { r.k0 = *(const u32x4*)(s.K + (size_t)(kb + (tid >> 3)) * s.kp + (tid & 7) * 8); }
DI void stage_store_k64(const StageRegs& r, LAS char* buf, int tid) { *(LAS u32x4*)(buf + (tid >> 3) * 144 + (tid & 7) * 16) = r.k0; }
DI void cmp_unit(const Ptrs& P, int b, int g, int qblk, LAS char* lds, int tid, int lane, int wid) {
    asm volatile("" : "+v"(tid), "+v"(lane));
    const int l31 = lane & 31, hi = lane >> 5, hh = wid & 3, qs = wid >> 2, h = 4 * g + hh, q0 = qblk * 64, q0w = q0 + 32 * qs, qpos = q0w + l31;
    const bf16* Hb = (const bf16*)(P.ws + WS_H);
    bf16x8 qf[4]; load_q<64>(qf, Hb + (size_t)(b * S + qpos) * HW + C_NQ + h * 64, hi);
    const float slope2 = __builtin_amdgcn_exp2f(-(float)(h + 1)) * LOG2E, c2 = 0.125f * LOG2E;
    KVSrc src; src.K = (const bf16*)(P.dob + DO_KC) + (size_t)((b * 2 + g) * 512) * 64; src.kp = 64; src.K2 = nullptr; src.Vt = (const bf16*)(P.dob + DO_VCT) + (size_t)((b * 2 + g) * 64) * 512; src.vp = 512;
    const int nt = (((q0 + 32) >> 4) >> 6) + 1;
    constexpr int KSB = 144, VOFF = 64 * KSB;
    const int koff = pi_row(l31) * KSB + hi * 16, voff = VOFF + l31 * 144 + hi * 16;
    float m = NEGF, l = 0.f; StageRegs sr;
    stage_load_k64(sr, src, 0, tid); stage_store_k64(sr, lds, tid); __syncthreads();
    for (int t = 0; t < nt; ++t) {
        if (t + 1 < nt) stage_load_k64(sr, src, 64 * (t + 1), tid);
        const LAS char* buf = lds + (t & 1) * CSTG;
        f32x16 s0, s1; qk_tile<64>(s0, s1, buf, qf, koff);
        const int dql = qpos - 31 - 1024 * t - 128 * hi;
        score_fix<M_CMP, true>(s0, s1, c2, slope2, dql, 1024 * t + 1039 > q0w, true);
        const float mx = tile_max(s0, s1), mn = fmaxf(m, mx); l *= __builtin_amdgcn_exp2f(m - mn); m = mn;
        float sum = 0.f;
#pragma unroll
        for (int r = 0; r < 16; ++r) sum += __builtin_amdgcn_exp2f(s0[r] - m) + __builtin_amdgcn_exp2f(s1[r] - m);
        l += sum;
        if (t + 1 < nt) stage_store_k64(sr, lds + ((t + 1) & 1) * CSTG, tid);
        __syncthreads();
    }
    const float inv = (m > -1e29f) ? 1.f / xh_sum(l) : 0.f;
    f32x16 o[2];
#pragma unroll
    for (int r = 0; r < 16; ++r) { o[0][r] = 0.f; o[1][r] = 0.f; }
    LAS float* prow = (LAS float*)(lds + C_PROW) + (wid * 32 + l31) * 68;
    float* impg = (float*)(P.ws + WS_ACMP) + (size_t)((b * 2 + g) * 128) * S + q0;
    float carry = 0.f;
    stage_load<64, 64>(sr, src, 0, tid); stage_store<64, 64>(sr, lds, tid); __syncthreads();
    for (int t = 0; t <= nt; ++t) {
        if (t > 0) {
            const LAS float* ih = (const LAS float*)(lds + C_IMPH) + ((t - 1) & 1) * 4096; const int q = tid & 63, nb = (tid >> 6) * 2;
            f32x2 a = *(const LAS f32x2*)(ih + q * 16 + nb); a += *(const LAS f32x2*)(ih + 1024 + q * 16 + nb); a += *(const LAS f32x2*)(ih + 2048 + q * 16 + nb); a += *(const LAS f32x2*)(ih + 3072 + q * 16 + nb);
            impg[(size_t)(16 * (t - 1) + nb) * S + q] = a.x; impg[(size_t)(16 * (t - 1) + nb + 1) * S + q] = a.y;
        }
        if (t == nt) break;
        if (t + 1 < nt) stage_load<64, 64>(sr, src, 64 * (t + 1), tid);
        const LAS char* buf = lds + (t & 1) * CSTG;
        f32x16 s0, s1; qk_tile<64>(s0, s1, buf, qf, koff);
        const int dql = qpos - 31 - 1024 * t - 128 * hi;
        score_fix<M_CMP, true>(s0, s1, c2, slope2, dql, 1024 * t + 1039 > q0w, true);
#pragma unroll
        for (int r = 0; r < 16; ++r) { s0[r] = __builtin_amdgcn_exp2f(s0[r] - m) * inv; s1[r] = __builtin_amdgcn_exp2f(s1[r] - m) * inv; }
        bf16x8 pf[4]; pack_p(pf, s0, s1);
        { bf16x8 v0[4]; v_load4(v0, buf, voff, 0); pv_tile<64>(o, buf, pf, voff, v0); }
        if (t > 0) carry = prow[63];
#pragma unroll
        for (int j = 0; j < 2; ++j) {
            *(LAS f32x4*)(prow + 16 * j + 8 * hi) = (f32x4){s0[8 * j], s0[8 * j + 1], s0[8 * j + 2], s0[8 * j + 3]}; *(LAS f32x4*)(prow + 16 * j + 8 * hi + 4) = (f32x4){s0[8 * j + 4], s0[8 * j + 5], s0[8 * j + 6], s0[8 * j + 7]};
            *(LAS f32x4*)(prow + 32 + 16 * j + 8 * hi) = (f32x4){s1[8 * j], s1[8 * j + 1], s1[8 * j + 2], s1[8 * j + 3]}; *(LAS f32x4*)(prow + 32 + 16 * j + 8 * hi + 4) = (f32x4){s1[8 * j + 4], s1[8 * j + 5], s1[8 * j + 6], s1[8 * j + 7]}; }
        asm volatile("s_waitcnt lgkmcnt(0)" ::: "memory");
        {
            float prev = hi ? prow[31] : carry; float iv[8];
#pragma unroll
            for (int k = 0; k < 8; ++k) { const f32x4 p4 = *(const LAS f32x4*)(prow + 32 * hi + 4 * k); iv[k] = 0.5f * prev + p4[0] + p4[1] + p4[2] + 0.5f * p4[3]; prev = p4[3]; }
            LAS float* ih = (LAS float*)(lds + C_IMPH) + (t & 1) * 4096 + hh * 1024 + (32 * qs + l31) * 16 + 8 * hi;
            *(LAS f32x4*)ih = (f32x4){iv[0], iv[1], iv[2], iv[3]}; *(LAS f32x4*)(ih + 4) = (f32x4){iv[4], iv[5], iv[6], iv[7]};
        }
        if (t + 1 < nt) stage_store<64, 64>(sr, lds + ((t + 1) & 1) * CSTG, tid);
        __syncthreads();
    }
    for (int i = tid; i < 64 * (128 - 16 * nt); i += 512) { const int q = i & 63, n = 16 * nt + (i >> 6); impg[(size_t)n * S + q] = 0.f; }
    float* oc = (float*)(P.dob + DO_OC) + (size_t)(b * S + qpos) * 512 + h * 64;
#pragma unroll
    for (int blk = 0; blk < 2; ++blk)
#pragma unroll
        for (int rr = 0; rr < 4; ++rr) *(f32x4*)(oc + 32 * blk + 8 * rr + 4 * hi) = (f32x4){o[blk][4 * rr], o[blk][4 * rr + 1], o[blk][4 * rr + 2], o[blk][4 * rr + 3]};
    __syncthreads();
}
constexpr int UKSB = 528, USTG = 64 * UKSB;
DI void upproj_unit(const Ptrs& P, int rb, int j, LAS char* lds, int tid, int lane, int wid) {
    asm volatile("" : "+v"(tid), "+v"(lane));
    const int l31 = lane & 31, hi = lane >> 5; const size_t row = (size_t)rb * 256 + wid * 32 + l31;
    const int koff = pi_row(l31) * UKSB + hi * 16;
    const bf16* WQ = (const bf16*)(P.ws + WS_WUQ); const bf16* WKV = (const bf16*)(P.ws + WS_WUKV);
    bf16x8 qf[16]; int have = -1;
    u32x4 sr[4];
#define UP_TILE(i, SRC, NT) const int SRC = (j == 0) ? ((i) < 12 ? 0 : 1) : 1; const int NT = (j == 0) ? ((i) < 12 ? (i) : (i) - 12) : (i) + 2
#define UP_LOAD(i) { UP_TILE(i, s_, n_); const char* wt = (const char*)((s_ ? WKV : WQ) + (size_t)n_ * 64 * 256); _Pragma("unroll") for (int c = 0; c < 4; ++c) sr[c] = *(const u32x4*)(wt + (size_t)(tid + 512 * c) * 16); }
#define UP_STORE(buf) { _Pragma("unroll") for (int c = 0; c < 4; ++c) { const int ch = tid + 512 * c; *(LAS u32x4*)((buf) + (ch >> 5) * UKSB + (ch & 31) * 16) = sr[c]; } }
    UP_LOAD(0); UP_STORE(lds); __syncthreads();
    for (int i = 0; i < 14; ++i) {
        UP_TILE(i, src, nt);
        if (i + 1 < 14) UP_LOAD(i + 1);
        if (src != have) { const bf16* A = (const bf16*)(P.ws + (src ? WS_KVLN : WS_QLN)) + row * 256 + hi * 8;
#pragma unroll
            for (int d0 = 0; d0 < 16; ++d0) qf[d0] = *(const bf16x8*)(A + d0 * 16);
            have = src; }
        const LAS char* buf = lds + (i & 1) * USTG;
        f32x16 s0, s1;
#pragma unroll
        for (int r = 0; r < 16; ++r) { s0[r] = 0.f; s1[r] = 0.f; }
        bf16x8 f0 = *(const LAS bf16x8*)(buf + koff), f1 = *(const LAS bf16x8*)(buf + koff + 32 * UKSB);
#pragma unroll
        for (int d0 = 0; d0 < 16; ++d0) { bf16x8 n0 = f0, n1 = f1;
            if (d0 + 1 < 16) { n0 = *(const LAS bf16x8*)(buf + koff + (d0 + 1) * 32); n1 = *(const LAS bf16x8*)(buf + koff + 32 * UKSB + (d0 + 1) * 32); }
            s0 = MFMA32(f0, qf[d0], s0); s1 = MFMA32(f1, qf[d0], s1); f0 = n0; f1 = n1; }
        bf16x8 pf[4]; pack_p(pf, s0, s1);
        bf16* orow = (bf16*)(P.ws + (src ? WS_KV : WS_QRAW)) + row * (src ? 1024 : 768) + nt * 64 + 8 * hi;
        *(bf16x8*)(orow) = pf[0]; *(bf16x8*)(orow + 16) = pf[1]; *(bf16x8*)(orow + 32) = pf[2]; *(bf16x8*)(orow + 48) = pf[3];
        if (i + 1 < 14) UP_STORE(lds + ((i + 1) & 1) * USTG);
        __syncthreads();
    }
#undef UP_TILE
#undef UP_LOAD
#undef UP_STORE
}

DI void transpose_item(const float* W, int K, int N, int Npad, bf16* WT, int row_off, LAS float* scr, int item, int lane) {
    const int nblk = Npad / 32, kb = item / nblk, nb = item % nblk, k0 = 64 * kb, n0 = 32 * nb; const int nn = n0 + (lane & 31); const bool okn = nn < N;
#pragma unroll 8
    for (int i = 0; i < 32; ++i) { const int kk = 2 * i + (lane >> 5); scr[kk * 33 + (lane & 31)] = okn ? W[(size_t)(k0 + kk) * N + nn] : 0.f; }
    asm volatile("s_waitcnt lgkmcnt(0)" ::: "memory");
    const int c = lane & 7;
#pragma unroll
    for (int j = 0; j < 4; ++j) { const int n = (lane >> 3) + 8 * j; const LAS float* s = scr + (8 * c) * 33 + n;
        u32x4 o; o.x = pk2(s[0 * 33], s[1 * 33]); o.y = pk2(s[2 * 33], s[3 * 33]); o.z = pk2(s[4 * 33], s[5 * 33]); o.w = pk2(s[6 * 33], s[7 * 33]);
        *(u32x4*)(WT + (size_t)(row_off + n0 + n) * K + k0 + 8 * c) = o; }
    asm volatile("s_waitcnt lgkmcnt(0)" ::: "memory");
}
DI void wave_transpose64(const bf16* src, size_t pitch, bf16* dst_row, int lane) {
    unsigned w[32];
#pragma unroll
    for (int k = 0; k < 32; ++k) { const unsigned a = src[(size_t)(2 * k) * pitch + lane], b = src[(size_t)(2 * k + 1) * pitch + lane]; w[k] = a | (b << 16); }
#pragma unroll
    for (int k = 0; k < 8; ++k) *(u32x4*)(dst_row + 8 * k) = (u32x4){w[4 * k], w[4 * k + 1], w[4 * k + 2], w[4 * k + 3]};
}
template <bool FINAL> DI void ln_row(const float* zrow, const float* g, const float* b, bf16* xn, float* st, float* outrow, int lane) {
    f32x4 v[4]; float s = 0.f;
#pragma unroll
    for (int j = 0; j < 4; ++j) { v[j] = *(const f32x4*)(zrow + 256 * j + 4 * lane); s += (v[j].x + v[j].y) + (v[j].z + v[j].w); }
    const float mean = wave_sum(s) * (1.f / 1024.f); float s2 = 0.f;
#pragma unroll
    for (int j = 0; j < 4; ++j) { v[j] = v[j] - mean; s2 += (v[j].x * v[j].x + v[j].y * v[j].y) + (v[j].z * v[j].z + v[j].w * v[j].w); }
    const float rstd = 1.f / sqrtf(wave_sum(s2) * (1.f / 1024.f) + LN_EPS);
#pragma unroll
    for (int j = 0; j < 4; ++j) { const f32x4 gv = *(const f32x4*)(g + 256 * j + 4 * lane), bv = *(const f32x4*)(b + 256 * j + 4 * lane); const f32x4 o = v[j] * rstd * gv + bv;
        if (FINAL) *(f32x4*)(outrow + 256 * j + 4 * lane) = o; else { u32x2 w; w.x = pk2(o.x, o.y); w.y = pk2(o.z, o.w); *(u32x2*)(xn + 256 * j + 4 * lane) = w; } }
    if (!FINAL) { if (lane == 0) { st[0] = mean; st[1] = rstd; } }
}
template <bool FINAL> DI void ln_rows4(const float* z, size_t m0, size_t stride, const float* g, const float* b, bf16* xn, float* st, float* out, int lane) {
    f32x4 v[4][4]; float mean[4], rstd[4];
#pragma unroll
    for (int r = 0; r < 4; ++r)
#pragma unroll
        for (int j = 0; j < 4; ++j) v[r][j] = *(const f32x4*)(z + (m0 + r * stride) * D + 256 * j + 4 * lane);
#pragma unroll
    for (int r = 0; r < 4; ++r) { float s = 0.f;
#pragma unroll
        for (int j = 0; j < 4; ++j) s += (v[r][j].x + v[r][j].y) + (v[r][j].z + v[r][j].w);
        mean[r] = s; }
#pragma unroll
    for (int o = 1; o < 64; o <<= 1) {
#pragma unroll
        for (int r = 0; r < 4; ++r) mean[r] += __shfl_xor(mean[r], o); }
#pragma unroll
    for (int r = 0; r < 4; ++r) { mean[r] *= (1.f / 1024.f); float s2 = 0.f;
#pragma unroll
        for (int j = 0; j < 4; ++j) { v[r][j] = v[r][j] - mean[r]; s2 += (v[r][j].x * v[r][j].x + v[r][j].y * v[r][j].y) + (v[r][j].z * v[r][j].z + v[r][j].w * v[r][j].w); }
        rstd[r] = s2; }
#pragma unroll
    for (int o = 1; o < 64; o <<= 1) {
#pragma unroll
        for (int r = 0; r < 4; ++r) rstd[r] += __shfl_xor(rstd[r], o); }
#pragma unroll
    for (int r = 0; r < 4; ++r) rstd[r] = 1.f / sqrtf(rstd[r] * (1.f / 1024.f) + LN_EPS);
#pragma unroll
    for (int j = 0; j < 4; ++j) { const f32x4 gv = *(const f32x4*)(g + 256 * j + 4 * lane), bv = *(const f32x4*)(b + 256 * j + 4 * lane);
#pragma unroll
        for (int r = 0; r < 4; ++r) { const f32x4 o = v[r][j] * rstd[r] * gv + bv; const size_t row = m0 + r * stride;
            if (FINAL) *(f32x4*)(out + row * D + 256 * j + 4 * lane) = o; else { u32x2 w; w.x = pk2(o.x, o.y); w.y = pk2(o.z, o.w); *(u32x2*)(xn + row * D + 256 * j + 4 * lane) = w; } } }
    if (!FINAL) { if (lane < 4) { const int r = lane; const float mm = (r == 0) ? mean[0] : (r == 1) ? mean[1] : (r == 2) ? mean[2] : mean[3], rr = (r == 0) ? rstd[0] : (r == 1) ? rstd[1] : (r == 2) ? rstd[2] : rstd[3];
        *(f32x2*)(st + 2 * (m0 + r * stride)) = (f32x2){mm, rr}; } }
}
DI void sincos_d(double a, float& c, float& s) {
    const double TWO_PI = 6.283185307179586476925286766559; const double k = __builtin_rint(a / TWO_PI); double r = a - k * TWO_PI;
    const double r2 = r * r; double cs = 1.0, sn = r, tc = 1.0, ts = r;
#pragma unroll 1
    for (int i = 1; i <= 14; ++i) { tc = -tc * r2 / (double)((2 * i - 1) * (2 * i)); ts = -ts * r2 / (double)((2 * i) * (2 * i + 1)); cs += tc; sn += ts; }
    c = (float)cs; s = (float)sn;
}

struct Args { const float* in[32]; float* out; unsigned char* ws; int ph_lo, ph_hi; };
constexpr int NPHASE = 22;
constexpr int XB_LDS_OFF = LDS_BYTES - 128;
#ifndef REP_ATT
#define REP_ATT 1
#endif
#ifndef REP_GEMM
#define REP_GEMM 1
#endif
#ifndef REP_MISC
#define REP_MISC 1
#endif
#define RA for (int rep_ = 0; rep_ < REP_ATT; ++rep_)
#define RG for (int rep_ = 0; rep_ < REP_GEMM; ++rep_)
#define RM for (int rep_ = 0; rep_ < REP_MISC; ++rep_)

#define GEMM_PHASE(EPI, Aptr, Bptr, M_, N_, K_, ...) do { pg8::Gemm g_{(const pg8::bf16_t*)(Aptr), (const pg8::bf16_t*)(Bptr), (M_), (N_), (K_)}; pg8::StaticOrder S_; S_.init((M_), (N_), G, bid); \
    EPI E_{__VA_ARGS__}; pg8::gemm_phase<EPI, pg8::StaticOrder, true, true>(lds, g_, S_, E_); } while (0)

__global__ void __launch_bounds__(512, 2) mega_fwd(Args args) {
    extern __shared__ __attribute__((aligned(16))) unsigned char lds_raw[];
    LAS unsigned char* lds = (LAS unsigned char*)lds_raw;
    cg::grid_group grid = cg::this_grid();
    const int tid = threadIdx.x, lane = tid & 63, wid = __builtin_amdgcn_readfirstlane(tid >> 6), G = gridDim.x, bid = blockIdx.x;
    const int vcu = vcu_of(bid, G), gw = vcu * 8 + wid, NGW = G * 8;
    Ptrs P;
#pragma unroll
    for (int i = 0; i < 32; ++i) P.in[i] = args.in[i];
    P.out = args.out; P.ws = args.ws; P.dob = (unsigned char*)args.out;
    unsigned char* ws = args.ws; unsigned char* dob = P.dob;
    const int lo = args.ph_lo, hi_ph = args.ph_hi;
#define IN(k) (lo <= (k) && (k) < hi_ph)
#define SEAM(k) do { if (IN(k) && IN((k) + 1)) { if ((k) == 0) grid.sync(); else xcd_barrier(xbar); } } while (0)
    { volatile LAS unsigned* stw = (volatile LAS unsigned*)(lds + XB_LDS_OFF); if (tid == 0) { stw[0] = 0u; stw[1] = 0u; } __syncthreads(); }
    XcdBarrier xbar = xcd_barrier_post((unsigned*)(ws + WS_CTL), (volatile LAS unsigned*)(lds + XB_LDS_OFF));
    float* stats = (float*)(ws + WS_STATS);
    bf16* Hb = (bf16*)(ws + WS_H); bf16* XB = (bf16*)(ws + WS_XB);

#ifdef PROBE_SYNCS
    if (lo == 0) { for (int i_ = 0; i_ < PROBE_SYNCS; ++i_) grid.sync(); }
#endif
    if (IN(0)) RM {
        LAS float* scr = (LAS float*)(lds + wid * 16384);
        constexpr int I0 = 16 * 64, I1 = 4 * 24, I2 = 4 * 32, I3 = 32 * 2, I4 = 32 * 2, I5 = 32 * 4, I6 = 16 * 32, I7 = 16 * 128, I8 = 64 * 32, I9 = 16 * 96, I10 = 16 * 32, I11 = 16 * 128, I12 = 64 * 32;
        constexpr int NIT = I0 + I1 + I2 + I3 + I4 + I5 + I6 + I7 + I8 + I9 + I10 + I11 + I12;
        for (int it = gw; it < NIT; it += NGW) { int r = it;
            if (r < I0) { transpose_item(P.in[1], 1024, L0W, 2048, (bf16*)(ws + WS_WIN), 0, scr, r, lane); continue; } r -= I0;
            if (r < I1) { transpose_item(P.in[3], 256, 768, 768, (bf16*)(ws + WS_WUQ), 0, scr, r, lane); continue; } r -= I1;
            if (r < I2) { transpose_item(P.in[5], 256, 1024, 1024, (bf16*)(ws + WS_WUKV), 0, scr, r, lane); continue; } r -= I2;
            if (r < I3) { transpose_item(P.in[7], 2048, 64, 64, (bf16*)(ws + WS_W1), 0, scr, r, lane); continue; } r -= I3;
            if (r < I4) { transpose_item(P.in[10], 2048, 64, 64, (bf16*)(ws + WS_W1), 64, scr, r, lane); continue; } r -= I4;
            if (r < I5) { transpose_item(P.in[7], 2048, 0, 128, (bf16*)(ws + WS_W1), 128, scr, r, lane); continue; } r -= I5;
            if (r < I6) { transpose_item(P.in[12], 1024, 1024, 1024, (bf16*)(ws + WS_WOUT), 0, scr, r, lane); continue; } r -= I6;
            if (r < I7) { transpose_item(P.in[15], 1024, 4096, 4096, (bf16*)(ws + WS_WUP0), 0, scr, r, lane); continue; } r -= I7;
            if (r < I8) { transpose_item(P.in[16], 4096, 1024, 1024, (bf16*)(ws + WS_WDN0), 0, scr, r, lane); continue; } r -= I8;
            if (r < I9) { transpose_item(P.in[19], 1024, 3072, 3072, (bf16*)(ws + WS_WQKV), 0, scr, r, lane); continue; } r -= I9;
            if (r < I10) { transpose_item(P.in[25], 1024, 1024, 1024, (bf16*)(ws + WS_WO), 0, scr, r, lane); continue; } r -= I10;
            if (r < I11) { transpose_item(P.in[28], 1024, 4096, 4096, (bf16*)(ws + WS_WUP1), 0, scr, r, lane); continue; } r -= I11;
            transpose_item(P.in[29], 4096, 1024, 1024, (bf16*)(ws + WS_WDN1), 0, scr, r, lane);
        }
        for (int m = gw; m < T; m += 4 * NGW) { f32x4 v[4][4];
#pragma unroll
            for (int r = 0; r < 4; ++r)
#pragma unroll
                for (int j = 0; j < 4; ++j) v[r][j] = *(const f32x4*)(P.in[0] + (size_t)(m + r * NGW) * D + 256 * j + 4 * lane);
#pragma unroll
            for (int r = 0; r < 4; ++r)
#pragma unroll
                for (int j = 0; j < 4; ++j) { u32x2 w; w.x = pk2(v[r][j].x, v[r][j].y); w.y = pk2(v[r][j].z, v[r][j].w); *(u32x2*)(XB + (size_t)(m + r * NGW) * D + 256 * j + 4 * lane) = w; } }
        { const float INV[16] = {1.f, 0.562341332f, 0.316227764f, 0.177827939f, 0.100000001f, 0.0562341288f, 0.0316227786f, 0.0177827943f, 0.00999999978f, 0.00562341325f, 0.00316227786f, 0.00177827943f, 0.00100000005f, 0.000562341302f, 0.000316227786f, 0.00017782794f};
          f32x2* rope = (f32x2*)(dob + DO_ROPE);
          for (int idx = bid * 512 + tid; idx < S * 16; idx += G * 512) { const int i = idx & 15, t = idx >> 4; float inv = INV[0];
#pragma unroll
              for (int k = 1; k < 16; ++k) inv = (i == k) ? INV[k] : inv;
              const float ang = (float)t * inv; float c, s; sincos_d((double)ang, c, s); rope[idx] = (f32x2){c, s}; } }
    }
    SEAM(0);
    if (IN(1)) RG GEMM_PHASE(pg8::EpiB16<0>, XB, ws + WS_WIN, T, HW, D, Hb, HW);
    SEAM(1);
    if (IN(2)) RM {
        const f32x2* rope = (const f32x2*)(dob + DO_ROPE);
        LAS unsigned* knl = (LAS unsigned*)lds;
        if (tid < 16) knl[tid] = 0u;
        __syncthreads();
        for (int row = gw; row < T; row += NGW) { const bf16* hr = Hb + (size_t)row * HW; const int t = row & (S - 1);
            { const float a0 = bf2f(hr[C_KS + lane]), a1 = bf2f(hr[C_KS + 64 + lane]), b0 = bf2f(hr[C_KW + lane]), b1 = bf2f(hr[C_KW + 64 + lane]);
              const float n0 = wave_sum(a0 * a0), n1 = wave_sum(a1 * a1), n2 = wave_sum(b0 * b0), n3 = wave_sum(b1 * b1); const int bb = row >> 13;
              if (lane == 0) { __hip_atomic_fetch_max(&knl[bb * 2], __builtin_bit_cast(unsigned, n0), __ATOMIC_RELAXED, __HIP_MEMORY_SCOPE_WORKGROUP); __hip_atomic_fetch_max(&knl[bb * 2 + 1], __builtin_bit_cast(unsigned, n1), __ATOMIC_RELAXED, __HIP_MEMORY_SCOPE_WORKGROUP); __hip_atomic_fetch_max(&knl[8 + bb * 2], __builtin_bit_cast(unsigned, n2), __ATOMIC_RELAXED, __HIP_MEMORY_SCOPE_WORKGROUP); __hip_atomic_fetch_max(&knl[8 + bb * 2 + 1], __builtin_bit_cast(unsigned, n3), __ATOMIC_RELAXED, __HIP_MEMORY_SCOPE_WORKGROUP); } }
#pragma unroll
            for (int which = 0; which < 2; ++which) { const u32x2 w = *(const u32x2*)(hr + which * 256 + 4 * lane); const float x0 = bf2f(w.x & 0xffffu), x1 = bf2f(w.x >> 16), x2 = bf2f(w.y & 0xffffu), x3 = bf2f(w.y >> 16);
                const float ss = wave_sum(x0 * x0 + x1 * x1 + x2 * x2 + x3 * x3); const float r = 1.f / sqrtf(ss * (1.f / 256.f) + RMS_EPS);
                const f32x4 gn = *(const f32x4*)(P.in[which ? 4 : 2] + 4 * lane); u32x2 o; o.x = pk2(x0 * r * gn.x, x1 * r * gn.y); o.y = pk2(x2 * r * gn.z, x3 * r * gn.w);
                *(u32x2*)((bf16*)(ws + (which ? WS_KVLN : WS_QLN)) + (size_t)row * 256 + 4 * lane) = o; }
            if (lane < 16) { const float x1 = bf2f(hr[C_KROPE + lane]), x2 = bf2f(hr[C_KROPE + 16 + lane]); const f32x2 cs = rope[t * 16 + lane]; bf16* kp = (bf16*)(dob + DO_KPE) + (size_t)row * 32;
                kp[lane] = (bf16)f2bf(x1 * cs.x - x2 * cs.y); kp[16 + lane] = (bf16)f2bf(x1 * cs.y + x2 * cs.x); }
            if (lane < 24) { const float v = bf2f(hr[C_GATE + lane]); ((float*)(dob + DO_GATE))[(size_t)row * 24 + lane] = 1.f / (1.f + __expf(-v)); }
        }
        for (int r = gw; r < 8192; r += NGW) { const int kv = r >> 12, rr = r & 4095, g = rr & 1, bi = rr >> 1, b = bi >> 9, i = bi & 511; bf16* dst = (bf16*)(ws + WS_ACMP) + (size_t)r * 2048;
            const float* pos = P.in[kv ? 9 : 6]; const int cb = (kv ? C_VC : C_KC) + g * 64;
#pragma unroll
            for (int it = 0; it < 8; ++it) { const int l = it * 4 + (lane >> 4), d4 = (lane & 15) * 4; u32x2 o = {0u, 0u};
                if (i < 511) { const u32x2 w = *(const u32x2*)(Hb + (size_t)(b * S + 16 * i + l) * HW + cb + d4); const f32x4 pv = *(const f32x4*)(pos + l * 64 + d4);
                    o.x = pk2(bf2f(w.x & 0xffffu) + pv.x, bf2f(w.x >> 16) + pv.y); o.y = pk2(bf2f(w.y & 0xffffu) + pv.z, bf2f(w.y >> 16) + pv.w); }
                *(u32x2*)(dst + l * 64 + d4) = o; } }
        for (int it = gw; it < 2048; it += NGW) { const int which = it >> 10, r = it & 1023, bg = r >> 7, tb = r & 127, b = bg >> 1, g = bg & 1;
            wave_transpose64(Hb + (size_t)(b * S + tb * 64) * HW + (which ? C_VW : C_VS) + g * 64, HW, (bf16*)(ws + (which ? WS_VTW : WS_VTS)) + (size_t)(bg * 64 + lane) * S + tb * 64, lane); }
        __syncthreads();
        if (tid < 16) atomicMax((unsigned*)(ws + WS_CTL) + KN_WORD + 64 + tid, knl[tid]);
    }
    SEAM(2);
    if (IN(3)) {
        GEMM_PHASE(pg8::EpiF32<3>, ws + WS_ACMP, ws + WS_W1, 8192, 256, 2048, (float*)(dob + DO_CH), 256);
        { unsigned* qc = (unsigned*)(ws + WS_CTL) + 3703; volatile LAS int* qs = (volatile LAS int*)(lds + LDS_BYTES - 256);
          for (;;) { __syncthreads(); if (tid == 0) *qs = (int)atomicAdd(qc, 1u); __syncthreads(); const int e = *qs; if (e >= 256) break;
              upproj_unit(P, e >> 1, e & 1, (LAS char*)lds, tid, lane, wid); } }
    }
    SEAM(3);
    if (IN(4)) RM {
        for (int r = gw; r < 8192; r += NGW) { const int kv = r >> 12, rr = r & 4095, g = rr & 1, bi = rr >> 1, b = bi >> 9, i = bi & 511;
            const float* ch = (const float*)(dob + DO_CH) + (size_t)r * 256 + kv * 64; const float* w2 = P.in[kv ? 11 : 8]; float acc = 0.f;
#pragma unroll 8
            for (int c = 0; c < 64; ++c) acc = __builtin_fmaf(ch[c], w2[c * 64 + lane], acc);
            if (kv == 0) ((bf16*)(dob + DO_KC))[(size_t)((b * 2 + g) * 512 + i) * 64 + lane] = (bf16)f2bf(acc);
            else ((bf16*)(dob + DO_VCT))[(size_t)((b * 2 + g) * 64 + lane) * 512 + i] = (bf16)f2bf(acc); }
        for (int it = gw; it < 4096; it += NGW) { const int bh = it >> 7, tb = it & 127, b = bh >> 3, h = bh & 7;
            wave_transpose64((const bf16*)(ws + WS_KV) + (size_t)(b * S + tb * 64) * 1024 + h * 128 + 64, 1024, (bf16*)(ws + WS_QLN) + (size_t)(bh * 64 + lane) * S + tb * 64, lane); }
    }
    SEAM(4);
    if (IN(5)) RA {
        for (int p = vcu; p < 512; p += G) { const int bh = p >> 4, s = p & 15; mla_unit(P, bh >> 3, bh & 7, 31 - s, (LAS char*)lds, tid, lane, wid); mla_unit(P, bh >> 3, bh & 7, s, (LAS char*)lds, tid, lane, wid); }
        for (int u = vcu; u < 1024; u += G) { const int bg = u & 7, qblk = u >> 3; cmp_unit(P, bg >> 1, bg & 1, qblk, (LAS char*)lds, tid, lane, wid); }
    }
    SEAM(5);
    if (IN(6)) RM {
        const float* imp = (const float*)(ws + WS_ACMP); unsigned* selm = (unsigned*)(dob + DO_SELM);
        for (int it = gw; it < NB * 2 * S / 64; it += NGW) { const int bg = it >> 7, q = ((it & 127) << 6) + lane, cur = q >> 6; const float* ip = imp + (size_t)(bg * 128) * S + q;
            float w[128];
#pragma unroll
            for (int n = 0; n < 128; ++n) { const float v = ip[(size_t)n * S]; const bool forced = (n == 0 || n == cur || n == cur - 1); w[n] = (n <= cur) ? (forced ? -3.0e38f : v) : NEGF; }
            unsigned m0 = 1u, m1 = 0u, m2 = 0u, m3 = 0u;
            { const unsigned bc = 1u << (cur & 31); const int wc_ = cur >> 5; m0 |= (wc_ == 0) ? bc : 0u; m1 |= (wc_ == 1) ? bc : 0u; m2 |= (wc_ == 2) ? bc : 0u; m3 |= (wc_ == 3) ? bc : 0u;
              const int cp = cur > 0 ? cur - 1 : 0; const unsigned bp = 1u << (cp & 31); const int wp_ = cp >> 5; m0 |= (wp_ == 0) ? bp : 0u; m1 |= (wp_ == 1) ? bp : 0u; m2 |= (wp_ == 2) ? bp : 0u; m3 |= (wp_ == 3) ? bp : 0u; }
#pragma unroll 1
            for (int r = 0; r < 13; ++r) {
                float a = mx3(w[0], w[1], w[2]), c = mx3(w[3], w[4], w[5]);
#pragma unroll
                for (int n = 6; n < 126; n += 4) { a = mx3(a, w[n], w[n + 1]); c = mx3(c, w[n + 2], w[n + 3]); }
                const float mxv = mx3(a, c, fmaxf(w[126], w[127]));
                int idx = 0;
#pragma unroll
                for (int n = 127; n >= 0; --n) idx = (w[n] == mxv) ? n : idx;
#pragma unroll
                for (int n = 0; n < 128; ++n) w[n] = (n == idx) ? -3.0e38f : w[n];
                const unsigned bit = (mxv > -1e29f) ? (1u << (idx & 31)) : 0u; const int wsel = idx >> 5;
                m0 |= (wsel == 0) ? bit : 0u; m1 |= (wsel == 1) ? bit : 0u; m2 |= (wsel == 2) ? bit : 0u; m3 |= (wsel == 3) ? bit : 0u;
            }
            *(u32x4*)(selm + ((size_t)bg * S + q) * 4) = (u32x4){m0, m1, m2, m3}; }
    }
    SEAM(6);
    if (IN(7)) {
        unsigned* qc = (unsigned*)(ws + WS_CTL) + 3700; volatile LAS int* qs = (volatile LAS int*)(lds + LDS_BYTES - 256); int e = vcu;
        while (e < 1024) { int nx = 0; if (tid == 0) nx = 256 + (int)atomicAdd(qc, 1u);
            const int h = 7 - (e >> 7), b = (e >> 5) & 3, qb = e & 31;
            nsa_sw_unit(P, b, h, qb, (LAS char*)lds, tid, lane, wid);
            __syncthreads(); if (tid == 0) *qs = nx; __syncthreads(); e = *qs; }
    }
    SEAM(7);
    if (IN(8)) RG GEMM_PHASE(pg8::EpiResid<0>, XB, ws + WS_WOUT, T, D, D, P.in[0], nullptr, nullptr, nullptr, P.out, ALPHA);
    SEAM(8);
    if (IN(9)) RM { for (int m = gw; m < T; m += 4 * NGW) ln_rows4<false>(P.out, (size_t)m, (size_t)NGW, P.in[13], P.in[14], XB, stats, nullptr, lane); }
    SEAM(9);
    if (IN(10)) RG GEMM_PHASE(pg8::EpiB16<2>, XB, ws + WS_WUP0, T, FF, D, (pg8::bf16_t*)(ws + WS_HID), FF);
    SEAM(10);
    if (IN(11)) RG GEMM_PHASE(pg8::EpiResid<1>, ws + WS_HID, ws + WS_WDN0, T, D, FF, P.out, stats, P.in[13], P.in[14], (float*)(ws + WS_H), ALPHA);
    SEAM(11);
    if (IN(12)) RM { for (int m = gw; m < T; m += 4 * NGW) ln_rows4<false>((const float*)(ws + WS_H), (size_t)m, (size_t)NGW, P.in[17], P.in[18], XB, stats + 2 * (size_t)T, nullptr, lane); }
    SEAM(12);
    if (IN(13)) RG GEMM_PHASE(pg8::EpiB16<0>, XB, ws + WS_WQKV, T, 3072, D, (pg8::bf16_t*)(ws + WS_QKV), 3072);
    SEAM(13);
    if (IN(14)) RM { for (int it = gw; it < 8192; it += NGW) { const int half = it & 1, r = it >> 1, bh = r >> 7, tb = r & 127, b = bh >> 3, h = bh & 7;
            wave_transpose64((const bf16*)(ws + WS_QKV) + (size_t)(b * S + tb * 64) * 3072 + 2048 + h * 128 + half * 64, 3072, (bf16*)(ws + WS_VTD) + (size_t)(bh * 128 + half * 64 + lane) * S + tb * 64, lane); }
        for (int it = gw; it < 8192; it += NGW) { const int bhj = it >> 7, tb = it & 127, b = bhj >> 4, h = (bhj >> 1) & 7, j = bhj & 1;
            const bf16* kr = (const bf16*)(ws + WS_QKV) + (size_t)(b * S + tb * 64 + lane) * 3072 + 1024 + h * 128 + j * 64; float ss = 0.f;
#pragma unroll
            for (int c = 0; c < 8; ++c) { const u32x4 w = *(const u32x4*)(kr + 8 * c);
#pragma unroll
                for (int e = 0; e < 4; ++e) { const float x0 = bf2f(w[e] & 0xffffu), x1 = bf2f(w[e] >> 16); ss += x0 * x0 + x1 * x1; } }
#pragma unroll
            for (int o = 1; o < 64; o <<= 1) ss = fmaxf(ss, __shfl_xor(ss, o));
            if (lane == 0) atomicMax((unsigned*)(ws + WS_CTL) + KN_WORD + bhj, __builtin_bit_cast(unsigned, ss)); }
    }
    SEAM(14);
    if (IN(15)) {
        unsigned* qc = (unsigned*)(ws + WS_CTL) + 3701; volatile LAS int* qs = (volatile LAS int*)(lds + LDS_BYTES - 256); int e = vcu;
        while (e < 2048) { int nx = 0; if (tid == 0) nx = 256 + (int)atomicAdd(qc, 1u);
            const int h = 7 - (e >> 8), bj = (e >> 5) & 7, b = bj >> 1, j = bj & 1, qb = 31 - (e & 31);
            diff_unit(P, b, h, j, qb, (LAS char*)lds, tid, lane, wid);
            __syncthreads(); if (tid == 0) *qs = nx; __syncthreads(); e = *qs; }
    }
    SEAM(15);
    if (IN(16)) RM {
        const float a1 = wave_sum(P.in[20][lane] * P.in[21][lane]), a2 = wave_sum(P.in[22][lane] * P.in[23][lane]); const float lam = __expf(a1) - __expf(a2) + LAM_INIT;
        const bf16* OD = (const bf16*)dob; const int hh = lane >> 3, e0 = (lane & 7) * 16;
        for (int m0 = gw; m0 < T; m0 += 4 * NGW) { u32x4 w1[4][2], w2[4][2];
#pragma unroll
            for (int r = 0; r < 4; ++r) { const bf16* o1 = OD + (size_t)(m0 + r * NGW) * 2048 + hh * 256 + e0;
#pragma unroll
                for (int c = 0; c < 2; ++c) { w1[r][c] = *(const u32x4*)(o1 + 8 * c); w2[r][c] = *(const u32x4*)(o1 + 128 + 8 * c); } }
#pragma unroll
            for (int r = 0; r < 4; ++r) { const int m = m0 + r * NGW; float v[16]; float ss = 0.f;
#pragma unroll
                for (int c = 0; c < 2; ++c)
#pragma unroll
                    for (int e = 0; e < 4; ++e) { v[8 * c + 2 * e] = bf2f(w1[r][c][e] & 0xffffu) - lam * bf2f(w2[r][c][e] & 0xffffu); v[8 * c + 2 * e + 1] = bf2f(w1[r][c][e] >> 16) - lam * bf2f(w2[r][c][e] >> 16); }
#pragma unroll
                for (int e = 0; e < 16; ++e) ss += v[e] * v[e];
                ss += __shfl_xor(ss, 1); ss += __shfl_xor(ss, 2); ss += __shfl_xor(ss, 4);
                const float rr = (1.f - LAM_INIT) / sqrtf(ss * (1.f / 128.f) + RMS_EPS); const float* sg = P.in[24] + e0; bf16* dst = XB + (size_t)m * D + hh * 128 + e0;
#pragma unroll
                for (int c = 0; c < 2; ++c) { u32x4 w;
#pragma unroll
                    for (int e = 0; e < 4; ++e) w[e] = pk2(v[8 * c + 2 * e] * rr * sg[8 * c + 2 * e], v[8 * c + 2 * e + 1] * rr * sg[8 * c + 2 * e + 1]);
                    *(u32x4*)(dst + 8 * c) = w; } } }
    }
    SEAM(16);
    if (IN(17)) RG GEMM_PHASE(pg8::EpiResid<1>, XB, ws + WS_WO, T, D, D, (const float*)(ws + WS_H), stats + 2 * (size_t)T, P.in[17], P.in[18], P.out, ALPHA);
    SEAM(17);
    if (IN(18)) RM { for (int m = gw; m < T; m += 4 * NGW) ln_rows4<false>(P.out, (size_t)m, (size_t)NGW, P.in[26], P.in[27], XB, stats + 4 * (size_t)T, nullptr, lane); }
    SEAM(18);
    if (IN(19)) RG GEMM_PHASE(pg8::EpiB16<2>, XB, ws + WS_WUP1, T, FF, D, (pg8::bf16_t*)(ws + WS_HID), FF);
    SEAM(19);
    if (IN(20)) RG GEMM_PHASE(pg8::EpiResid<1>, ws + WS_HID, ws + WS_WDN1, T, D, FF, P.out, stats + 2 * (size_t)(2 * T), P.in[26], P.in[27], (float*)(ws + WS_H), ALPHA);
    SEAM(20);
    if (IN(21)) RM { for (int m = gw; m < T; m += 4 * NGW) ln_rows4<true>((const float*)(ws + WS_H), (size_t)m, (size_t)NGW, P.in[30], P.in[31], nullptr, nullptr, P.out, lane); }
#undef IN
#undef SEAM
}

extern "C" void kernel_launch(void* const* d_in, const int* in_sizes, int n_in, void* d_out, int out_size, void* d_ws, size_t ws_size, hipStream_t stream) {
    static int grid = 0;
    if (grid == 0) {
        if (n_in != 32 || out_size != T * D || ws_size < WS_CTL + 16384) { fprintf(stderr, "kernel_launch: unexpected shapes (n_in %d out %d ws %zu)\n", n_in, out_size, ws_size); grid = -1; return; }
        int dev = 0, cus = 0, per_cu = 0;
        hipGetDevice(&dev); hipDeviceGetAttribute(&cus, hipDeviceAttributeMultiprocessorCount, dev);
        hipFuncSetAttribute((const void*)mega_fwd, hipFuncAttributeMaxDynamicSharedMemorySize, LDS_BYTES);
        hipOccupancyMaxActiveBlocksPerMultiprocessor(&per_cu, (const void*)mega_fwd, 512, LDS_BYTES);
        if (per_cu < 1) { fprintf(stderr, "kernel_launch: occupancy query says %d blocks per CU\n", per_cu); per_cu = 1; }
        (void)hipGetLastError();
        grid = cus * per_cu;
        if (grid > 256) grid = 256;
        if (grid < 256) { fprintf(stderr, "kernel_launch: only %d co-resident workgroups; this kernel needs 256\n", grid); grid = -1; return; }
    }
    if (grid < 0) return;
    if (hipMemsetAsync((char*)d_ws + WS_CTL, 0, 16384, stream) != hipSuccess) { fprintf(stderr, "kernel_launch: memset failed\n"); return; }
    Args a{};
    for (int i = 0; i < 32; ++i) a.in[i] = (const float*)d_in[i];
    a.out = (float*)d_out; a.ws = (unsigned char*)d_ws;
#ifdef PROBE_SEQ
    static const int seq[][2] = PROBE_SEQ;
    for (unsigned si = 0; si < sizeof(seq) / sizeof(seq[0]); ++si) { const int ph = si; a.ph_lo = seq[si][0]; a.ph_hi = seq[si][1]; void* kargs[] = {&a}; if (si) (void)hipMemsetAsync((char*)d_ws + WS_CTL, 0, 16384, stream);
        hipError_t e = hipLaunchCooperativeKernel((const void*)mega_fwd, dim3(grid), dim3(512), kargs, LDS_BYTES, stream);
        if (e != hipSuccess) { fprintf(stderr, "launch phase %d failed: %s\n", ph, hipGetErrorString(e)); break; } }
#else
    a.ph_lo = 0; a.ph_hi = NPHASE; void* kargs[] = {&a};
    hipError_t e = hipLaunchCooperativeKernel((const void*)mega_fwd, dim3(grid), dim3(512), kargs, LDS_BYTES, stream);
    if (e != hipSuccess) fprintf(stderr, "cooperative launch failed: %s (grid %d)\n", hipGetErrorString(e), grid);
#endif
}
```
